# Optimizing an MI355X kernel written in HIP

```python
import math
import jax, jax.numpy as jnp
from jax import lax
import numpy as np

D_MODEL = 1024
BATCH = 8
SEQ = 2048
DEPTH = 2
DEC_BATCH = 128
DEC_SEQ = 8
PAST_LEN = 16384
PAGE_SIZE = 128

N_MIXERS = 4
G = D_MODEL // N_MIXERS
N_BLOCKS = 10
D_IN = N_BLOCKS * G
SC_WIDTH = 3
POOL_WINDOWS = (2, 4, 8, 16)
N_POOL = len(POOL_WINDOWS)
POOL_CH = G // N_POOL
POOL_BUF = max(POOL_WINDOWS) - 1
HGRN_HEADS = 4
HGRN_DK = G // HGRN_HEADS
HGRN_DV = G // HGRN_HEADS
HGRN_CHUNK = 64
CONF_WIDTH = 31
D_FF = -(-8 * D_MODEL // (3 * 256)) * 256
EPS = 1e-6
F_MIN = 1e-20

kernel_name = 'hybrid_shortconv_pool_hgrn2_conformer_step'


def rmsnorm(x, g):
    xf = x.astype(jnp.float32)
    y = xf * lax.rsqrt(jnp.mean(xf * xf, axis=-1, keepdims=True) + EPS)
    return (y * g.astype(jnp.float32)).astype(x.dtype)


def layernorm(x, g, b):
    xf = x.astype(jnp.float32)
    mu = jnp.mean(xf, axis=-1, keepdims=True)
    xc = xf - mu
    y = xc * lax.rsqrt(jnp.mean(xc * xc, axis=-1, keepdims=True) + EPS)
    return (y * g.astype(jnp.float32) + b.astype(jnp.float32)).astype(x.dtype)


def causal_dwconv(u, buf, w):
    width = w.shape[0]
    xx = jnp.concatenate([buf.astype(u.dtype), u], axis=1)
    y = lax.conv_general_dilated(xx, w.astype(u.dtype)[:, None, :], window_strides=(1,), padding='VALID',
                                 dimension_numbers=('NWC', 'WIO', 'NWC'), feature_group_count=u.shape[-1])
    return y, xx[:, xx.shape[1] - (width - 1):]


def multiscale_pool(p, buf, start_pos):
    n, t, _ = p.shape
    xx = jnp.concatenate([buf.astype(p.dtype), p], axis=1)
    cs = jnp.cumsum(xx.astype(jnp.float32), axis=1)
    cs = jnp.pad(cs, ((0, 0), (1, 0), (0, 0)))
    pos = start_pos + jnp.arange(t)
    outs = []
    for gi, w in enumerate(POOL_WINDOWS):
        sl = slice(gi * POOL_CH, (gi + 1) * POOL_CH)
        hi = cs[:, POOL_BUF + 1:POOL_BUF + 1 + t, sl]
        lo = cs[:, POOL_BUF + 1 - w:POOL_BUF + 1 - w + t, sl]
        cnt = jnp.minimum(pos + 1, w).astype(jnp.float32)
        outs.append((hi - lo) / cnt[None, :, None])
    mean = jnp.concatenate(outs, axis=-1)
    return (mean - p.astype(jnp.float32)).astype(p.dtype), xx[:, xx.shape[1] - POOL_BUF:]


def hgrn2_scan(q, k, v, logf, s0):
    n, t = q.shape[:2]
    c = min(HGRN_CHUNK, t)
    pad = (-t) % c
    if pad:
        pw = ((0, 0), (0, pad), (0, 0), (0, 0))
        q, k, v, logf = [jnp.pad(a, pw) for a in (q, k, v, logf)]
    nc = (t + pad) // c

    def to_chunks(a):
        return a.reshape(n, nc, c, *a.shape[2:]).swapaxes(0, 1)

    mask = jnp.tril(jnp.ones((c, c), dtype=bool))[None, :, :, None, None]

    def step(s, inp):
        qc, kc, vc, lc = inp
        b = jnp.cumsum(lc, axis=1)
        diff = b[:, :, None] - b[:, None]
        decay = jnp.where(mask, jnp.exp(jnp.minimum(diff, 0.0)), 0.0)
        attn = jnp.einsum('ntshk,nshk->nths', qc[:, :, None] * decay, kc)
        o = (jnp.einsum('nths,nshv->nthv', attn, vc)
             + jnp.einsum('nthk,nhkv->nthv', qc * jnp.exp(b), s))
        b_end = b[:, -1]
        s_new = (jnp.exp(b_end)[..., None] * s
                 + jnp.einsum('nshk,nshv->nhkv', kc * jnp.exp(b_end[:, None] - b), vc))
        return s_new, o

    s_fin, o = lax.scan(step, s0, (to_chunks(q), to_chunks(k), to_chunks(v), to_chunks(logf)))
    o = o.swapaxes(0, 1).reshape(n, nc * c, HGRN_HEADS, HGRN_DV)[:, :t]
    return o, s_fin


def hgrn2(zq, zf, zi, zg, lower, s0, norm_g):
    n, t, _ = zq.shape
    q = jax.nn.silu(zq.astype(jnp.float32).reshape(n, t, HGRN_HEADS, HGRN_DK))
    lb = lower.reshape(HGRN_HEADS, HGRN_DK)
    zf4 = zf.astype(jnp.float32).reshape(n, t, HGRN_HEADS, HGRN_DK)
    f = lb + (1.0 - lb) * jax.nn.sigmoid(zf4)
    logf = jnp.log(jnp.maximum(f, F_MIN))
    k = 1.0 - f
    v = zi.astype(jnp.float32).reshape(n, t, HGRN_HEADS, HGRN_DV)
    o, s = hgrn2_scan(q, k, v, logf, s0.astype(jnp.float32))
    o = o * lax.rsqrt(jnp.mean(o * o, axis=-1, keepdims=True) + EPS)
    o = o * norm_g.astype(jnp.float32).reshape(HGRN_HEADS, HGRN_DV)
    y = o.reshape(n, t, G) * jax.nn.silu(zg.astype(jnp.float32))
    return y.astype(zq.dtype), s.astype(s0.dtype)


def trunk(x, s_conv, s_pool, s_hgrn, s_conf, start_pos, wts):
    (norm_mix_pre, norm_mix_post, w_in, conv_w, pool_w, pool_scale, hgrn_lb, hgrn_norm,
     conf_dw, conf_b, conf_ln_g, conf_ln_b, w_out, norm_ffn_pre, norm_ffn_post,
     w_gate, w_up, w_down) = wts
    n, t, _ = x.shape
    sm = jax.nn.softmax(hgrn_lb.astype(jnp.float32), axis=0)
    lower = jnp.cumsum(sm, axis=0) - sm[0:1]
    new_conv, new_pool, new_hgrn, new_conf = [], [], [], []
    for l in range(DEPTH):
        h = rmsnorm(x, norm_mix_pre[l])
        (a_b, a_c, a_u, b_p, c_q, c_f, c_i, c_g, d_a, d_g) = jnp.split(h @ w_in[l], N_BLOCKS, axis=-1)
        ya, buf = causal_dwconv(a_c * a_u, s_conv[:, l], conv_w[l])
        ya = a_b * ya
        new_conv.append(buf)
        pooled, buf = multiscale_pool(b_p, s_pool[:, l], start_pos)
        yb = jnp.einsum('ntgc,gcd->ntgd', pooled.reshape(n, t, N_POOL, POOL_CH), pool_w[l])
        yb = yb.reshape(n, t, G) * pool_scale[l]
        new_pool.append(buf)
        yc, st = hgrn2(c_q, c_f, c_i, c_g, lower[l], s_hgrn[:, l], hgrn_norm[l])
        new_hgrn.append(st)
        u = d_a * jax.nn.sigmoid(d_g)
        yd, buf = causal_dwconv(u, s_conf[:, l], conf_dw[l])
        yd = jax.nn.silu(layernorm(yd + conf_b[l], conf_ln_g[l], conf_ln_b[l]))
        new_conf.append(buf)
        mix = jnp.concatenate([ya, yb, yc, yd], axis=-1) @ w_out[l]
        x = x + rmsnorm(mix, norm_mix_post[l])
        h = rmsnorm(x, norm_ffn_pre[l])
        ff = (jax.nn.silu(h @ w_gate[l]) * (h @ w_up[l])) @ w_down[l]
        x = x + rmsnorm(ff, norm_ffn_post[l])
    return (x, jnp.stack(new_conv, axis=1), jnp.stack(new_pool, axis=1),
            jnp.stack(new_hgrn, axis=1), jnp.stack(new_conf, axis=1))


def setup_inputs(seed: int = 0) -> dict:
    key = jax.random.key(seed)
    ks = jax.random.split(key, 32)

    def nrm(k, shape, s):
        return jax.random.normal(k, shape, jnp.float32) * s

    def gain(k, shape):
        return 1.0 + 0.05 * jax.random.normal(k, shape, jnp.float32)

    return {
        'x_prompt': nrm(ks[0], (BATCH, SEQ, D_MODEL), 1.0),
        'x_sample': nrm(ks[1], (DEC_BATCH, DEC_SEQ, D_MODEL), 1.0),
        'state_conv': nrm(ks[2], (DEC_BATCH, DEPTH, SC_WIDTH - 1, G), 1.0),
        'state_pool': nrm(ks[3], (DEC_BATCH, DEPTH, POOL_BUF, G), 1.0),
        'state_hgrn': nrm(ks[4], (DEC_BATCH, DEPTH, HGRN_HEADS, HGRN_DK, HGRN_DV), 0.5),
        'state_conf': nrm(ks[5], (DEC_BATCH, DEPTH, CONF_WIDTH - 1, G), 0.5),
        'norm_mix_pre': gain(ks[6], (DEPTH, D_MODEL)),
        'norm_mix_post': gain(ks[7], (DEPTH, D_MODEL)),
        'w_in': nrm(ks[8], (DEPTH, D_MODEL, D_IN), D_MODEL ** -0.5),
        'conv_w': nrm(ks[9], (DEPTH, SC_WIDTH, G), SC_WIDTH ** -0.5),
        'pool_w': nrm(ks[10], (DEPTH, N_POOL, POOL_CH, POOL_CH), POOL_CH ** -0.5),
        'pool_scale': gain(ks[11], (DEPTH, G)),
        'hgrn_lb': nrm(ks[12], (DEPTH, G), 0.5),
        'hgrn_norm': gain(ks[13], (DEPTH, G)),
        'conf_dw': nrm(ks[14], (DEPTH, CONF_WIDTH, G), CONF_WIDTH ** -0.5),
        'conf_b': nrm(ks[15], (DEPTH, G), 0.02),
        'conf_ln_g': gain(ks[16], (DEPTH, G)),
        'conf_ln_b': nrm(ks[17], (DEPTH, G), 0.02),
        'w_out': nrm(ks[18], (DEPTH, N_MIXERS * G, D_MODEL), (N_MIXERS * G) ** -0.5),
        'norm_ffn_pre': gain(ks[19], (DEPTH, D_MODEL)),
        'norm_ffn_post': gain(ks[20], (DEPTH, D_MODEL)),
        'w_gate': nrm(ks[21], (DEPTH, D_MODEL, D_FF), D_MODEL ** -0.5),
        'w_up': nrm(ks[22], (DEPTH, D_MODEL, D_FF), D_MODEL ** -0.5),
        'w_down': nrm(ks[23], (DEPTH, D_FF, D_MODEL), D_FF ** -0.5),
    }


def reference(x_prompt, x_sample, state_conv, state_pool, state_hgrn, state_conf,
              norm_mix_pre, norm_mix_post, w_in, conv_w, pool_w, pool_scale, hgrn_lb, hgrn_norm,
              conf_dw, conf_b, conf_ln_g, conf_ln_b, w_out, norm_ffn_pre, norm_ffn_post,
              w_gate, w_up, w_down):
    wts = (norm_mix_pre, norm_mix_post, w_in, conv_w, pool_w, pool_scale, hgrn_lb, hgrn_norm,
           conf_dw, conf_b, conf_ln_g, conf_ln_b, w_out, norm_ffn_pre, norm_ffn_post,
           w_gate, w_up, w_down)
    dt = x_prompt.dtype
    p_conv = jnp.zeros((BATCH, DEPTH, SC_WIDTH - 1, G), dt)
    p_pool = jnp.zeros((BATCH, DEPTH, POOL_BUF, G), dt)
    p_hgrn = jnp.zeros((BATCH, DEPTH, HGRN_HEADS, HGRN_DK, HGRN_DV), state_hgrn.dtype)
    p_conf = jnp.zeros((BATCH, DEPTH, CONF_WIDTH - 1, G), dt)
    y_prompt, conv_p, pool_p, hgrn_p, conf_p = trunk(x_prompt, p_conv, p_pool, p_hgrn, p_conf, 0, wts)
    y_sample, conv_s, pool_s, hgrn_s, conf_s = trunk(x_sample, state_conv, state_pool, state_hgrn,
                                                     state_conf, PAST_LEN, wts)
    return (y_prompt, y_sample, conv_p, pool_p, hgrn_p, conf_p, conv_s, pool_s, hgrn_s, conf_s)
```

```cpp
#include <hip/hip_runtime.h>
#include <cstdio>
#include <cstdint>

namespace pg8 {
#define PG8_LAS __attribute__((address_space(3)))
typedef unsigned short bf16_t;
typedef short bf16x8 __attribute__((ext_vector_type(8)));
typedef float f32x4 __attribute__((ext_vector_type(4)));
typedef unsigned u32x4 __attribute__((ext_vector_type(4)));
constexpr int BM = 256, BK = 64, HALF = 128, HTB = HALF * BK * 2  , STAGE_BYTES = 8 * HTB, NXCD = 8, WGM = 8;

__host__ __device__ __forceinline__ int lds_byte(int r, int c) { const int st = (r >> 4) * 2 + (c >> 5), rr = r & 15, cc = c & 31, ob = rr * 64 + cc * 2; return st * 1024 + (ob ^ (((ob >> 9) & 1) << 5)); }
__host__ __device__ __forceinline__ void stage_rc(int b, int& R, int& C) { const int st = b / 1024, sb = b % 1024, swz = sb ^ (((sb >> 9) & 1) << 5); R = (st >> 1) * 16 + swz / 64; C = (st & 1) * 32 + (swz % 64) / 2; }
__host__ __device__ __forceinline__ int perm32(int rho) { const int n = rho >> 4, i = rho & 15; return 8 * (i >> 2) + 4 * n + (i & 3); }

struct Unit { int pm, pn; };
struct Gemm { const bf16_t* A; const bf16_t* Bt; int M, N, K; };

struct StaticOrder {
    int nM, nN, nwg, G, c;
    __host__ __device__ void init(int M, int N, int G_, int c_) { nM = M / BM; nN = N / BM; nwg = nM * nN; G = G_; c = c_; }
    __host__ __device__ bool next(int i, Unit& u) const {
        const long L = (long)i * G + c; if (L >= nwg) return false;
        int wgid = (int)L; { const int q = nwg / NXCD, r = nwg % NXCD, xcd = wgid % NXCD, off = wgid / NXCD; wgid = (xcd < r ? xcd * (q + 1) : r * (q + 1) + (xcd - r) * q) + off; }
        const int nig = WGM * nN, gid = wgid / nig, fm = gid * WGM, gsz = (nM - fm) < WGM ? (nM - fm) : WGM;
        u.pm = fm + ((wgid % nig) % gsz); u.pn = (wgid % nig) / gsz; return true;
    }
    __device__ __forceinline__ void a_ready(const Unit&) const {}
    __device__ __forceinline__ void done(const Unit&) const {}
};

__device__ __forceinline__ unsigned cvt_pk_bf16(float lo, float hi) { unsigned r; asm volatile("v_cvt_pk_bf16_f32 %0, %1, %2" : "=v"(r) : "v"(lo), "v"(hi)); return r; }
__device__ __forceinline__ float fsigmoid(float x) { return __builtin_amdgcn_rcpf(1.0f + __expf(-x)); }
__device__ __forceinline__ float fsilu(float x) { return x * fsigmoid(x); }

struct EpiP {
    static constexpr bool PERM = true, AFTER_DRAIN = false;
    bf16_t* P; float* ZF;
    __device__ __forceinline__ void operator()(const f32x4 (&acc)[2][2][4][2], const Unit& u, int wr, int wc, int fr, int fq) const {
        const int row0 = u.pm * BM + wr * 64 + fr, col0 = wc * 32 + 8 * fq;
        if (u.pn == 5) {
#pragma unroll
            for (int ai = 0; ai < 2; ++ai)
#pragma unroll
                for (int m = 0; m < 4; ++m) { float* rowp = ZF + (size_t)(row0 + ai * HALF + m * 16) * 256 + col0;
#pragma unroll
                    for (int bj = 0; bj < 2; ++bj) { *(f32x4*)(rowp + bj * HALF) = acc[ai][bj][m][0]; *(f32x4*)(rowp + bj * HALF + 4) = acc[ai][bj][m][1]; } }
        } else {
#pragma unroll
            for (int ai = 0; ai < 2; ++ai)
#pragma unroll
                for (int m = 0; m < 4; ++m) { bf16_t* rowp = P + (size_t)(row0 + ai * HALF + m * 16) * 2560 + u.pn * BM + col0;
#pragma unroll
                    for (int bj = 0; bj < 2; ++bj) { const f32x4 v0 = acc[ai][bj][m][0], v1 = acc[ai][bj][m][1];
                        u32x4 w; w.x = cvt_pk_bf16(v0[0], v0[1]); w.y = cvt_pk_bf16(v0[2], v0[3]); w.z = cvt_pk_bf16(v1[0], v1[1]); w.w = cvt_pk_bf16(v1[2], v1[3]);
                        *(u32x4*)(rowp + bj * HALF) = w; } }
        }
    }
};
struct EpiBf {
    static constexpr bool PERM = true, AFTER_DRAIN = false;
    bf16_t* O; int ldc;
    __device__ __forceinline__ void operator()(const f32x4 (&acc)[2][2][4][2], const Unit& u, int wr, int wc, int fr, int fq) const {
        const int row0 = u.pm * BM + wr * 64 + fr, col0 = u.pn * BM + wc * 32 + 8 * fq;
#pragma unroll
        for (int ai = 0; ai < 2; ++ai)
#pragma unroll
            for (int m = 0; m < 4; ++m) { bf16_t* rowp = O + (size_t)(row0 + ai * HALF + m * 16) * ldc + col0;
#pragma unroll
                for (int bj = 0; bj < 2; ++bj) { const f32x4 v0 = acc[ai][bj][m][0], v1 = acc[ai][bj][m][1];
                    u32x4 w; w.x = cvt_pk_bf16(v0[0], v0[1]); w.y = cvt_pk_bf16(v0[2], v0[3]); w.z = cvt_pk_bf16(v1[0], v1[1]); w.w = cvt_pk_bf16(v1[2], v1[3]);
                    *(u32x4*)(rowp + bj * HALF) = w; } }
    }
};
struct EpiAct {
    static constexpr bool PERM = true, AFTER_DRAIN = false;
    bf16_t* O; int ldc;
    __device__ __forceinline__ void operator()(const f32x4 (&acc)[2][2][4][2], const Unit& u, int wr, int wc, int fr, int fq) const {
        const int row0 = u.pm * BM + wr * 64 + fr, col0 = u.pn * HALF + wc * 32 + 8 * fq;
#pragma unroll
        for (int ai = 0; ai < 2; ++ai)
#pragma unroll
            for (int m = 0; m < 4; ++m) { bf16_t* rowp = O + (size_t)(row0 + ai * HALF + m * 16) * ldc + col0;
                f32x4 r0, r1; const f32x4 g0 = acc[ai][0][m][0], g1 = acc[ai][0][m][1], u0 = acc[ai][1][m][0], u1 = acc[ai][1][m][1];
#pragma unroll
                for (int j = 0; j < 4; ++j) { r0[j] = fsilu(g0[j]) * u0[j]; r1[j] = fsilu(g1[j]) * u1[j]; }
                u32x4 w; w.x = cvt_pk_bf16(r0[0], r0[1]); w.y = cvt_pk_bf16(r0[2], r0[3]); w.z = cvt_pk_bf16(r1[0], r1[1]); w.w = cvt_pk_bf16(r1[2], r1[3]);
                *(u32x4*)rowp = w; }
    }
};

template <class Epi, class Sched, bool ALIGN_EPI = false, bool SP2 = false>
__device__ __forceinline__ void gemm_phase(PG8_LAS unsigned char* lds, const Gemm g, const Sched& S, const Epi& E) {
    const int tid = threadIdx.x, wid = __builtin_amdgcn_readfirstlane(tid >> 6), lane = tid & 63, wr = wid >> 2, wc = wid & 3, fr = lane & 15, fq = lane >> 4;
    const int K = g.K, nt = K / BK;
    unsigned voffA[2], voffB[2];
#pragma unroll
    for (int i = 0; i < 2; ++i) { int R, C; stage_rc(tid * 16 + i * 8192, R, C); const int Rb = Epi::PERM ? ((R & ~31) + perm32(R & 31)) : R;
        voffA[i] = (unsigned)(R * K + C) * 2u; voffB[i] = (unsigned)(Rb * K + C) * 2u; }
    const size_t kstep = (size_t)(BK * 2);
    const size_t hstep = (size_t)HALF * K * 2;
    const size_t tstep = 2 * hstep;
    const unsigned ldsw = (unsigned)wid * 1024u;
    const int aoff = lds_byte(wr * 64 + fr, fq * 8), boff = lds_byte(wc * 32 + fr, fq * 8);
#define PG8_SA(b, h) (((b) * 2 + (h)) * HTB)
#define PG8_SB(b, h) ((4 + (b) * 2 + (h)) * HTB)
#define PG8_STAGE(bufoff, gbase, voff) do { _Pragma("unroll") for (int _i = 0; _i < 2; ++_i) \
        __builtin_amdgcn_global_load_lds((const unsigned*)((const char*)(gbase) + (voff)[_i]), (PG8_LAS unsigned*)(lds + (bufoff) + ldsw + _i * 8192), 16, 0, 0); } while (0)
#define PG8_LDA(dst, b, h) do { _Pragma("unroll") for (int m = 0; m < 4; ++m) _Pragma("unroll") for (int k = 0; k < 2; ++k) dst[m][k] = *(const PG8_LAS bf16x8*)(lds + PG8_SA(b, h) + aoff + m * 2048 + k * 1024); } while (0)
#define PG8_LDB(dst, b, h) do { _Pragma("unroll") for (int n = 0; n < 2; ++n) _Pragma("unroll") for (int k = 0; k < 2; ++k) dst[n][k] = *(const PG8_LAS bf16x8*)(lds + PG8_SB(b, h) + boff + n * 2048 + k * 1024); } while (0)
#define PG8_MMA(ai, bj, At, Bt) do { __builtin_amdgcn_s_setprio(1); _Pragma("unroll") for (int m = 0; m < 4; ++m) _Pragma("unroll") for (int n = 0; n < 2; ++n) _Pragma("unroll") for (int k = 0; k < 2; ++k) \
        acc[ai][bj][m][n] = __builtin_amdgcn_mfma_f32_16x16x32_bf16(Bt[n][k], At[m][k], acc[ai][bj][m][n], 0, 0, 0); __builtin_amdgcn_s_setprio(0); } while (0)
#define PG8_WAIT_V(n) asm volatile("s_waitcnt vmcnt(" #n ")" ::: "memory")
#define PG8_WAIT_L(n) asm volatile("s_waitcnt lgkmcnt(" #n ")" ::: "memory")
#define PG8_BAR __builtin_amdgcn_s_barrier()
#define PG8_SCHED __builtin_amdgcn_sched_barrier(0)
    Unit cur, nxt; int ui = 0;
    if (!S.next(0, cur)) return;
    f32x4 acc[2][2][4][2];
#pragma unroll
    for (int a = 0; a < 2; ++a)
#pragma unroll
        for (int b = 0; b < 2; ++b)
#pragma unroll
            for (int m = 0; m < 4; ++m)
#pragma unroll
                for (int n = 0; n < 2; ++n) acc[a][b][m][n] = (f32x4){0.f, 0.f, 0.f, 0.f};
    bf16x8 At[4][2], B0[2][2], B1[2][2];
    const char* cA = (const char*)g.A + (size_t)cur.pm * tstep; const char* cB = (const char*)g.Bt + (size_t)cur.pn * tstep;
    S.a_ready(cur);
    if constexpr (SP2) {
        PG8_STAGE(PG8_SB(0, 0), cB, voffB); PG8_STAGE(PG8_SB(0, 1), cB + hstep, voffB); PG8_STAGE(PG8_SA(0, 0), cA, voffA); PG8_STAGE(PG8_SA(0, 1), cA + hstep, voffA);
        if (wr == 1) PG8_BAR;
        PG8_WAIT_V(2); PG8_BAR;
        PG8_STAGE(PG8_SB(1, 0), cB + kstep, voffB); PG8_STAGE(PG8_SA(1, 0), cA + kstep, voffA); PG8_STAGE(PG8_SB(1, 1), cB + hstep + kstep, voffB);
        PG8_WAIT_V(6); PG8_BAR;
    } else {
        PG8_STAGE(PG8_SB(0, 0), cB, voffB); PG8_STAGE(PG8_SA(0, 0), cA, voffA); PG8_STAGE(PG8_SB(0, 1), cB + hstep, voffB); PG8_STAGE(PG8_SA(0, 1), cA + hstep, voffA);
        if (wr == 1) PG8_BAR;
        PG8_WAIT_V(4); PG8_BAR;
        PG8_STAGE(PG8_SB(1, 0), cB + kstep, voffB); PG8_STAGE(PG8_SA(1, 0), cA + kstep, voffA); PG8_STAGE(PG8_SB(1, 1), cB + hstep + kstep, voffB);
        PG8_WAIT_V(6); PG8_BAR;
    }
    for (;;) {
        const bool has_next = S.next(ui + 1, nxt);
        const char* nA = has_next ? (const char*)g.A + (size_t)nxt.pm * tstep : cA; const char* nB = has_next ? (const char*)g.Bt + (size_t)nxt.pn * tstep : cB;
        for (int t = 0; t < nt; t += 2) {
            const bool last = (t == nt - 2);
            const char* a1 = cA + (size_t)(t + 1) * kstep;
            const char* a2 = last ? nA : cA + (size_t)(t + 2) * kstep; const char* b2 = last ? nB : cB + (size_t)(t + 2) * kstep;
            const char* a3 = a2 + kstep; const char* b3 = b2 + kstep;
            if (last && has_next) S.a_ready(nxt);
            if constexpr (SP2) {
            PG8_LDB(B0, 0, 0); PG8_LDB(B1, 0, 1); PG8_SCHED; PG8_LDA(At, 0, 0); PG8_STAGE(PG8_SA(1, 1), a1 + hstep, voffA);
            PG8_WAIT_V(8); PG8_WAIT_L(0); PG8_BAR; PG8_MMA(0, 0, At, B0); PG8_MMA(0, 1, At, B1); PG8_BAR; PG8_SCHED;
            PG8_LDA(At, 0, 1); PG8_STAGE(PG8_SB(0, 0), b2, voffB); PG8_STAGE(PG8_SB(0, 1), b2 + hstep, voffB); PG8_STAGE(PG8_SA(0, 0), a2, voffA);
            PG8_WAIT_V(8); PG8_WAIT_L(0); PG8_BAR; PG8_MMA(1, 0, At, B0); PG8_MMA(1, 1, At, B1); PG8_BAR; PG8_SCHED;
            PG8_LDB(B0, 1, 0); PG8_LDB(B1, 1, 1); PG8_SCHED; PG8_LDA(At, 1, 0); PG8_STAGE(PG8_SA(0, 1), a2 + hstep, voffA);
            PG8_WAIT_V(8); PG8_WAIT_L(0); PG8_BAR; PG8_MMA(0, 0, At, B0); PG8_MMA(0, 1, At, B1); PG8_BAR; PG8_SCHED;
            PG8_LDA(At, 1, 1); PG8_STAGE(PG8_SB(1, 0), b3, voffB); PG8_STAGE(PG8_SB(1, 1), b3 + hstep, voffB); PG8_STAGE(PG8_SA(1, 0), a3, voffA);
            PG8_WAIT_V(8); PG8_WAIT_L(0); PG8_BAR; PG8_MMA(1, 0, At, B0); PG8_MMA(1, 1, At, B1); PG8_BAR; PG8_SCHED;
            } else {
            PG8_LDB(B0, 0, 0); PG8_SCHED; PG8_LDA(At, 0, 0); PG8_STAGE(PG8_SA(1, 1), a1 + hstep, voffA);
            PG8_WAIT_L(8); PG8_BAR; PG8_WAIT_L(0); PG8_MMA(0, 0, At, B0); PG8_BAR; PG8_SCHED;
            PG8_LDB(B1, 0, 1); PG8_STAGE(PG8_SB(0, 0), b2, voffB);
            PG8_BAR; PG8_WAIT_L(0); PG8_MMA(0, 1, At, B1); PG8_BAR;
            PG8_LDA(At, 0, 1); PG8_STAGE(PG8_SA(0, 0), a2, voffA);
            PG8_BAR; PG8_WAIT_L(0); PG8_MMA(1, 0, At, B0); PG8_BAR; PG8_SCHED;
            PG8_STAGE(PG8_SB(0, 1), b2 + hstep, voffB);
            PG8_WAIT_V(6); PG8_BAR; PG8_MMA(1, 1, At, B1); PG8_BAR;
            PG8_LDB(B0, 1, 0); PG8_SCHED; PG8_LDA(At, 1, 0); PG8_STAGE(PG8_SA(0, 1), a2 + hstep, voffA);
            PG8_WAIT_L(8); PG8_BAR; PG8_WAIT_L(0); PG8_MMA(0, 0, At, B0); PG8_BAR; PG8_SCHED;
            PG8_LDB(B1, 1, 1); PG8_STAGE(PG8_SB(1, 0), b3, voffB);
            PG8_BAR; PG8_WAIT_L(0); PG8_MMA(0, 1, At, B1); PG8_BAR;
            PG8_LDA(At, 1, 1); PG8_STAGE(PG8_SA(1, 0), a3, voffA);
            PG8_BAR; PG8_WAIT_L(0); PG8_MMA(1, 0, At, B0); PG8_BAR; PG8_SCHED;
            PG8_STAGE(PG8_SB(1, 1), b3 + hstep, voffB);
            PG8_WAIT_V(6); PG8_BAR; PG8_MMA(1, 1, At, B1); PG8_BAR;
            }
        }
        if constexpr (ALIGN_EPI) { if (wr == 0) PG8_BAR; }
        if constexpr (!Epi::AFTER_DRAIN) { E(acc, cur, wr, wc, fr, fq); S.done(cur); }
        if (!has_next) break;
#pragma unroll
        for (int a = 0; a < 2; ++a)
#pragma unroll
            for (int b = 0; b < 2; ++b)
#pragma unroll
                for (int m = 0; m < 4; ++m)
#pragma unroll
                    for (int n = 0; n < 2; ++n) acc[a][b][m][n] = (f32x4){0.f, 0.f, 0.f, 0.f};
        cur = nxt; cA = nA; cB = nB; ++ui;
        if constexpr (ALIGN_EPI) { if (wr == 1) PG8_BAR; }
    }
    PG8_WAIT_V(0);
    if constexpr (!ALIGN_EPI) { if (wr == 0) PG8_BAR; }
    PG8_BAR;
    if constexpr (Epi::AFTER_DRAIN) { E.fused(acc, cur, wr, wc, fr, fq, lds, wid, lane); S.done(cur); }
#undef PG8_SA
#undef PG8_SB
#undef PG8_STAGE
#undef PG8_LDA
#undef PG8_LDB
#undef PG8_MMA
#undef PG8_WAIT_V
#undef PG8_WAIT_L
#undef PG8_BAR
#undef PG8_SCHED
}
}

#ifndef MK_N_LAUNCHES
#define MK_N_LAUNCHES 1
#endif

constexpr int NWAVES = 8;
constexpr int D = 1024, DEPTH = 2, G4 = 256, DIN = 2560, DFF = 2816;
constexpr int PB = 8, PS = 2048, SB = 128, SS = 8;
constexpr int MP = PB * PS;
constexpr int MS = SB * SS;
constexpr int M = MP + MS;
constexpr float EPS = 1e-6f, F_MIN = 1e-20f;
constexpr int NCH = PS / 64;

constexpr size_t O_Y = 0, O_CONVP = (size_t)M * D, O_POOLP = O_CONVP + 8 * 2 * 2 * 256, O_HGRNP = O_POOLP + 8 * 2 * 15 * 256, O_CONFP = O_HGRNP + 8 * 2 * 4 * 64 * 64,
                 O_CONVS = O_CONFP + 8 * 2 * 30 * 256, O_POOLS = O_CONVS + 128 * 2 * 2 * 256, O_HGRNS = O_POOLS + 128 * 2 * 15 * 256, O_CONFS = O_HGRNS + (size_t)128 * 2 * 4 * 64 * 64,
                 O_END = O_CONFS + 128 * 2 * 30 * 256;
static_assert(O_END == 25554944, "output size");

constexpr size_t MiB = 1u << 20;
constexpr size_t WS_CTL = 0, CTL_ZERO_BYTES = 1 * MiB;
constexpr size_t SZ_WIN = (size_t)DIN * D * 2, SZ_WOUT = (size_t)D * D * 2, SZ_W3 = (size_t)2 * DFF * D * 2, SZ_WDN = (size_t)D * DFF * 2, SZ_WL = SZ_WIN + SZ_WOUT + SZ_W3 + SZ_WDN;
constexpr size_t WS_W = 1 * MiB;
constexpr size_t WS_WPF = WS_W + 2 * SZ_WL;
constexpr size_t WS_XN = WS_WPF + 2 * MiB;
constexpr size_t WS_Y = WS_XN + (size_t)M * D * 2;
constexpr size_t WS_S0 = WS_Y + (size_t)M * D * 2;
constexpr size_t WS_R = WS_S0 + (size_t)8 * 4 * NCH * 4096 * 4;
constexpr size_t WS_P = WS_R, WS_ZF = WS_P + (size_t)M * DIN * 2, WS_ACT = WS_R, WS_MIX2 = WS_R, WS_MIX4 = WS_Y;
constexpr size_t WS_END = WS_ZF + (size_t)M * 256 * 4;
static_assert(WS_END <= 256 * MiB, "d_ws map");
static_assert((size_t)M * DFF * 2 <= WS_END - WS_R, "ACT fits the shared region");

constexpr int CW_TMO = 0, CW_CODE = 1, CW_BAR = 4096;

constexpr int RING_BYTES = 131072;
constexpr int LDS_BYTES = 147456;
constexpr int MISC_OFF = LDS_BYTES - 256;

#define GAS __attribute__((address_space(1)))
#define LAS __attribute__((address_space(3)))
typedef unsigned short bf16;
typedef unsigned v4u __attribute__((ext_vector_type(4)));
typedef unsigned v2u __attribute__((ext_vector_type(2)));
typedef float f32x4 __attribute__((ext_vector_type(4)));
typedef short bf16x8 __attribute__((ext_vector_type(8)));
typedef GAS unsigned gu32;
#define RLX_AGENT __ATOMIC_RELAXED, __HIP_MEMORY_SCOPE_AGENT
#define LDS_WAIT() asm volatile("s_waitcnt lgkmcnt(0)" ::: "memory")
#define VM_WAIT() asm volatile("s_waitcnt vmcnt(0)" ::: "memory")
__device__ __forceinline__ unsigned f2bf(float f) { unsigned u = __builtin_bit_cast(unsigned, f); return (u + 0x7fffu + ((u >> 16) & 1u)) >> 16; }
__device__ __forceinline__ unsigned pk2(float lo, float hi) { return f2bf(lo) | (f2bf(hi) << 16); }
__device__ __forceinline__ float bf2f(unsigned h) { return __builtin_bit_cast(float, h << 16); }
__device__ __forceinline__ float bflo(unsigned w) { return __builtin_bit_cast(float, w << 16); }
__device__ __forceinline__ float bfhi(unsigned w) { return __builtin_bit_cast(float, w & 0xffff0000u); }
using pg8::fsigmoid; using pg8::fsilu;

#define XB_TMO      128
#define XB_XCNT(j)  (256  + 64 * (j))
#define XB_XSUB(j)  (1280 + 64 * (j))
#define XB_XGEN(j)  (2304 + 64 * (j))
#define XB_TOP      3328
#define XB_TOPGEN   3392
#define XCD_BAR_WORDS 3456
#define XB_SPIN_CAP (1u << 18)

__device__ __forceinline__ unsigned xb_ld(unsigned* p)              { return __hip_atomic_load(p, __ATOMIC_RELAXED, __HIP_MEMORY_SCOPE_AGENT); }
__device__ __forceinline__ unsigned xb_add(unsigned* p, unsigned v) { return __hip_atomic_fetch_add(p, v, __ATOMIC_RELAXED, __HIP_MEMORY_SCOPE_AGENT); }
__device__ __forceinline__ unsigned xb_xcc_id() { return (unsigned)__builtin_amdgcn_s_getreg((3 << 11) | 20) & 0xFu; }
#define XB_SPIN(cond, bar) do { unsigned _sp = 0; while (cond) { __builtin_amdgcn_s_sleep(1); \
    if ((++_sp & 255u) == 0u) { if (xb_ld(&(bar)[XB_TMO])) break; if (_sp > XB_SPIN_CAP) { atomicAdd(&(bar)[XB_TMO], 1u); break; } } } } while (0)

struct XcdBarrier {
    unsigned* bar; unsigned x;
    volatile LAS unsigned* st;
};

__device__ __forceinline__ XcdBarrier xcd_barrier_post(unsigned* bar, volatile LAS unsigned* st) {
    XcdBarrier b; b.bar = bar; b.x = xb_xcc_id(); b.st = st;
    if (threadIdx.x == 0) (void)xb_add(&bar[XB_XCNT(b.x)], 1u);
    return b;
}
__device__ __forceinline__ void xcd_barrier_complete(unsigned* bar, unsigned x, unsigned& nloc, unsigned& nx) {
    const unsigned G = gridDim.x * gridDim.y * gridDim.z;
    unsigned sum, cnt, mine, sp = 0u;
    for (;;) {
        sum = 0u; cnt = 0u; mine = 0u;
#pragma unroll
        for (unsigned j = 0; j < 16; ++j) { const unsigned c = xb_ld(&bar[XB_XCNT(j)]); sum += c; cnt += (c > 0u) ? 1u : 0u; mine = (j == x) ? c : mine; }
        if (sum == G) break;
        __builtin_amdgcn_s_sleep(1);
        if ((++sp & 255u) == 0u) { if (xb_ld(&bar[XB_TMO])) break; if (sp > XB_SPIN_CAP) { atomicAdd(&bar[XB_TMO], 1u); break; } }
    }
    nloc = mine > 0u ? mine : 1u; nx = cnt > 0u ? cnt : 1u;
}

__device__ __forceinline__ void xcd_barrier(const XcdBarrier& b) {
    asm volatile("s_waitcnt vmcnt(0)" ::: "memory");
    __syncthreads();
    if (threadIdx.x == 0) {
        unsigned* bar = b.bar;
        __builtin_amdgcn_s_waitcnt(0);
        unsigned nloc = b.st[0], nx = b.st[1];
        if (nloc == 0u) { xcd_barrier_complete(bar, b.x, nloc, nx); b.st[0] = nloc; b.st[1] = nx; }
        const unsigned old = xb_add(&bar[XB_XSUB(b.x)], 1u);
        const unsigned gen = old / nloc;
        if (old + 1u == (gen + 1u) * nloc) {
            __builtin_amdgcn_fence(__ATOMIC_RELEASE, "agent");
            asm volatile("s_waitcnt vmcnt(0)" ::: "memory");
            const unsigned og = xb_add(&bar[XB_TOP], 1u);
            const unsigned tg = og / nx;
            if (og + 1u == (tg + 1u) * nx) xb_add(&bar[XB_TOPGEN], 1u);
            else XB_SPIN(xb_ld(&bar[XB_TOPGEN]) == tg, bar);
            __builtin_amdgcn_fence(__ATOMIC_ACQUIRE, "agent");
            xb_add(&bar[XB_XGEN(b.x)], 1u);
            asm volatile("s_waitcnt vmcnt(0)" ::: "memory");
        } else {
            XB_SPIN(xb_ld(&bar[XB_XGEN(b.x)]) == gen, bar);
            __builtin_amdgcn_fence(__ATOMIC_ACQUIRE, "agent");
            asm volatile("s_waitcnt vmcnt(0)" ::: "memory");
        }
    }
    __syncthreads();
}

struct Args { const float* in[24]; float* out; unsigned char* ws; int ph_lo, ph_hi, li, pad; };
struct Frame {
    LAS unsigned char* lds;
    int tid, lane, wave, vcu, G;
};
__device__ __forceinline__ float wave_sum(float v) {
#pragma unroll
    for (int o = 1; o < 64; o <<= 1) v += __shfl_xor(v, o);
    return v;
}

__device__ __forceinline__ void wt_item(const float* W, int ldw, int col0, int ksrc0, bf16* WT, int K, int out_row0, int kdst0, LAS float* scr, int lane) {
#pragma unroll 8
    for (int i = 0; i < 32; ++i) { const int kk = 2 * i + (lane >> 5); scr[kk * 33 + (lane & 31)] = W[(size_t)(ksrc0 + kk) * ldw + col0 + (lane & 31)]; }
    LDS_WAIT(); asm volatile("" ::: "memory");
    const int c = lane & 7;
#pragma unroll
    for (int j = 0; j < 4; ++j) { const int n = (lane >> 3) + 8 * j; const LAS float* s = scr + (8 * c) * 33 + n;
        v4u o; o.x = pk2(s[0 * 33], s[1 * 33]); o.y = pk2(s[2 * 33], s[3 * 33]); o.z = pk2(s[4 * 33], s[5 * 33]); o.w = pk2(s[6 * 33], s[7 * 33]);
        *(GAS v4u*)(WT + (size_t)(out_row0 + n) * K + kdst0 + 8 * c) = o; }
    LDS_WAIT(); asm volatile("" ::: "memory");
}
constexpr int IT_WIN = (D / 64) * (DIN / 32);
constexpr int IT_WOUT = (D / 64) * (D / 32);
constexpr int IT_W3 = (D / 64) * (2 * DFF / 32);
constexpr int IT_WDN = (DFF / 64) * (D / 32);
constexpr int IT_LAYER = IT_WIN + IT_WOUT + IT_W3 + IT_WDN;
__device__ __forceinline__ bf16* w_in_t(unsigned char* ws, int l) { return (bf16*)(ws + WS_W + (size_t)l * SZ_WL); }
__device__ __forceinline__ bf16* w_out_t(unsigned char* ws, int l) { return (bf16*)(ws + WS_W + (size_t)l * SZ_WL + SZ_WIN); }
__device__ __forceinline__ bf16* w_3_t(unsigned char* ws, int l) { return (bf16*)(ws + WS_W + (size_t)l * SZ_WL + SZ_WIN + SZ_WOUT); }
__device__ __forceinline__ bf16* w_dn_t(unsigned char* ws, int l) { return (bf16*)(ws + WS_W + (size_t)l * SZ_WL + SZ_WIN + SZ_WOUT + SZ_W3); }

__device__ __forceinline__ void phase0(const Frame& F, const Args& a) {
    LAS float* scr = (LAS float*)(F.lds + F.wave * 16384);
    const int gw = F.vcu * NWAVES + F.wave, NGW = F.G * NWAVES;
    for (int it = gw; it < DEPTH * IT_LAYER; it += NGW) {
        const int l = it / IT_LAYER; int r = it % IT_LAYER;
        if (r < IT_WIN) { const int nblk = DIN / 32, kb = r / nblk, nb = r % nblk;
            wt_item(a.in[8] + (size_t)l * D * DIN, DIN, 32 * nb, 64 * kb, w_in_t(a.ws, l), D, 32 * nb, 64 * kb, scr, F.lane); continue; }
        r -= IT_WIN;
        if (r < IT_WOUT) { const int nblk = D / 32, kb = r / nblk, nb = r % nblk;
            if (kb >= 4 && kb < 8) continue;
            wt_item(a.in[18] + (size_t)l * D * D, D, 32 * nb, 64 * kb, w_out_t(a.ws, l), D, 32 * nb, 64 * kb, scr, F.lane); continue; }
        r -= IT_WOUT;
        if (r < IT_W3) { const int nblk = 2 * DFF / 32, kb = r / nblk, nb = r % nblk, R0 = 32 * nb, pn = R0 >> 8, within = R0 & 255, bj = within >> 7, j0 = within & 127;
            const float* W = (bj ? a.in[22] : a.in[21]) + (size_t)l * D * DFF;
            wt_item(W, DFF, pn * 128 + j0, 64 * kb, w_3_t(a.ws, l), D, R0, 64 * kb, scr, F.lane); continue; }
        r -= IT_W3;
        { const int nblk = D / 32, kb = r / nblk, nb = r % nblk;
            wt_item(a.in[23] + (size_t)l * DFF * D, D, 32 * nb, 64 * kb, w_dn_t(a.ws, l), DFF, 32 * nb, 64 * kb, scr, F.lane); }
    }
    for (int it = gw; it < DEPTH * 4 * (D / 64); it += NGW) {
        const int l = it / (4 * (D / 64)), g = (it / (D / 64)) % 4, n = (it % (D / 64)) * 64 + F.lane;
        const float* wo = a.in[18] + (size_t)l * D * D + (size_t)(256 + 64 * g) * D + n;
        const float* pw = a.in[10] + (size_t)(l * 4 + g) * 4096; const float* sc = a.in[11] + l * 256 + 64 * g;
        float* wpf = (float*)(a.ws + WS_WPF) + (size_t)l * 256 * D + (size_t)(64 * g) * D + n;
        float wv[64];
#pragma unroll
        for (int d = 0; d < 64; ++d) wv[d] = wo[(size_t)d * D] * sc[d];
        for (int c = 0; c < 64; ++c) { float s = 0.f;
#pragma unroll
            for (int d = 0; d < 64; ++d) s += pw[c * 64 + d] * wv[d];
            wpf[(size_t)c * D] = s; }
    }
    const float* g0 = a.in[6];
    for (int m = gw; m < M; m += NGW) {
        const float* xrow = (m < MP) ? a.in[0] + (size_t)m * D : a.in[1] + (size_t)(m - MP) * D;
        const GAS f32x4* xr = (const GAS f32x4*)xrow + F.lane;
        f32x4 v[4]; float s = 0.f;
#pragma unroll
        for (int j = 0; j < 4; ++j) { v[j] = xr[64 * j]; s += (v[j].x * v[j].x + v[j].y * v[j].y) + (v[j].z * v[j].z + v[j].w * v[j].w); }
        const float rs = 1.0f / sqrtf(wave_sum(s) * (1.f / D) + EPS);
        GAS f32x4* xo = (GAS f32x4*)(a.out + O_Y + (size_t)m * D) + F.lane;
        GAS v2u* o8 = (GAS v2u*)((bf16*)(a.ws + WS_XN) + (size_t)m * D) + F.lane;
#pragma unroll
        for (int j = 0; j < 4; ++j) { xo[64 * j] = v[j]; const f32x4 gg = *((const GAS f32x4*)g0 + F.lane + 64 * j);
            v2u w; w.x = pk2(v[j].x * rs * gg.x, v[j].y * rs * gg.y); w.y = pk2(v[j].z * rs * gg.z, v[j].w * rs * gg.w); o8[64 * j] = w; }
    }
}

__device__ __forceinline__ void phase_rows(const Frame& F, const Args& a, const bf16* mix, const float* ga, const float* gb  ) {
    const int gw = F.vcu * NWAVES + F.wave, NGW = F.G * NWAVES;
    for (int m = gw; m < M; m += NGW) {
        GAS f32x4* xo = (GAS f32x4*)(a.out + O_Y + (size_t)m * D) + F.lane;
        const GAS v2u* mr = (const GAS v2u*)(mix + (size_t)m * D) + F.lane;
        f32x4 x[4], mv[4]; float s = 0.f;
#pragma unroll
        for (int j = 0; j < 4; ++j) { x[j] = xo[64 * j]; const v2u w = mr[64 * j]; mv[j] = (f32x4){bflo(w.x), bfhi(w.x), bflo(w.y), bfhi(w.y)};
            s += (mv[j].x * mv[j].x + mv[j].y * mv[j].y) + (mv[j].z * mv[j].z + mv[j].w * mv[j].w); }
        const float rs = 1.0f / sqrtf(wave_sum(s) * (1.f / D) + EPS);
        float s2 = 0.f;
#pragma unroll
        for (int j = 0; j < 4; ++j) { const f32x4 gg = *((const GAS f32x4*)ga + F.lane + 64 * j); x[j] = x[j] + mv[j] * rs * gg; xo[64 * j] = x[j];
            s2 += (x[j].x * x[j].x + x[j].y * x[j].y) + (x[j].z * x[j].z + x[j].w * x[j].w); }
        if (gb) {
            const float rs2 = 1.0f / sqrtf(wave_sum(s2) * (1.f / D) + EPS);
            GAS v2u* o8 = (GAS v2u*)((bf16*)(a.ws + WS_XN) + (size_t)m * D) + F.lane;
#pragma unroll
            for (int j = 0; j < 4; ++j) { const f32x4 gg = *((const GAS f32x4*)gb + F.lane + 64 * j);
                v2u w; w.x = pk2(x[j].x * rs2 * gg.x, x[j].y * rs2 * gg.y); w.y = pk2(x[j].z * rs2 * gg.z, x[j].w * rs2 * gg.w); o8[64 * j] = w; }
        }
    }
}

__device__ __forceinline__ float hgrn_lower(const float* lbw, int l, int c) {
    if (l == 0) return 0.f;
    const float a0 = lbw[c], a1 = lbw[256 + c], mx = fmaxf(a0, a1), e0 = __expf(a0 - mx), e1 = __expf(a1 - mx);
    return e1 / (e0 + e1);
}
__device__ __forceinline__ void hgrn_scan_unit(const Frame& F, const Args& a, int l, int unit) {
    const int b = unit >> 5, h = (unit >> 3) & 3, vs = unit & 7;
    LAS float* SL = (LAS float*)F.lds;
    const float* ZF = (const float*)(a.ws + WS_ZF); const bf16* P = (const bf16*)(a.ws + WS_P);
    const float lb = hgrn_lower(a.in[12], l, h * 64 + F.lane);
    for (int ci = 0; ci < 4; ++ci) {
        const int c = F.wave + 8 * ci; const size_t row0 = (size_t)b * PS + c * 64;
        float S[8]; float Dp = 1.f;
#pragma unroll
        for (int j = 0; j < 8; ++j) S[j] = 0.f;
#pragma unroll 8
        for (int t = 0; t < 64; ++t) {
            const float z = ZF[(row0 + t) * 256 + h * 64 + F.lane];
            const v4u vv = *(const v4u*)(P + (row0 + t) * DIN + 6 * 256 + h * 64 + vs * 8);
            const float f = fmaxf(lb + (1.f - lb) * fsigmoid(z), F_MIN), k = 1.f - f;
            S[0] = f * S[0] + k * bflo(vv.x); S[1] = f * S[1] + k * bfhi(vv.x); S[2] = f * S[2] + k * bflo(vv.y); S[3] = f * S[3] + k * bfhi(vv.y);
            S[4] = f * S[4] + k * bflo(vv.z); S[5] = f * S[5] + k * bfhi(vv.z); S[6] = f * S[6] + k * bflo(vv.w); S[7] = f * S[7] + k * bfhi(vv.w);
            Dp *= f;
        }
        LAS float* o = SL + (c * 64 + F.lane) * 9;
#pragma unroll
        for (int j = 0; j < 8; ++j) o[j] = S[j];
        o[8] = Dp;
    }
    __syncthreads();
    {   const int k = F.tid & 63, v = F.tid >> 6;
        float* S0 = (float*)(a.ws + WS_S0) + ((size_t)(b * 4 + h) * NCH) * 4096 + (size_t)(vs * 8 + v) * 64 + k;
        float S = 0.f;
        for (int c = 0; c < NCH; ++c) { S0[(size_t)c * 4096] = S; const LAS float* e = SL + (c * 64 + k) * 9; S = e[8] * S + e[v]; }
        a.out[O_HGRNP + ((size_t)(b * DEPTH + l) * 4 + h) * 4096 + k * 64 + vs * 8 + v] = S;
    }
    __syncthreads();
}

__device__ __forceinline__ void mm64(const LAS unsigned char* A, const LAS unsigned char* Bt, f32x4 (&acc)[2], int wave, int lane) {
    const int rs = wave >> 1, ch = wave & 1, fr = lane & 15, fq = lane >> 4;
#pragma unroll
    for (int ks = 0; ks < 2; ++ks) {
        const bf16x8 av = *(const LAS bf16x8*)(A + (16 * rs + fr) * 144 + (ks * 32 + 8 * fq) * 2);
#pragma unroll
        for (int nt = 0; nt < 2; ++nt) {
            const bf16x8 bv = *(const LAS bf16x8*)(Bt + (32 * ch + 16 * nt + fr) * 144 + (ks * 32 + 8 * fq) * 2);
            acc[nt] = __builtin_amdgcn_mfma_f32_16x16x32_bf16(av, bv, acc[nt], 0, 0, 0);
        }
    }
}

__device__ __forceinline__ void hgrn_out_unit(const Frame& F, const Args& a, int l, int unit) {
    const int b = unit >> 7, c = (unit >> 2) & 31, h = unit & 3;
    const size_t row0 = (size_t)b * PS + c * 64;
    LAS unsigned char* QT = F.lds, *KT = F.lds + 9216, *VT = F.lds + 18432, *AM = F.lds + 27648, *ST = F.lds + 36864;
    LAS float* OF = (LAS float*)(F.lds + 46080);
    LAS float* PART = (LAS float*)(F.lds + 62720);
    LAS float* ER = (LAS float*)(F.lds + 64768);
    const float* ZF = (const float*)(a.ws + WS_ZF); const bf16* P = (const bf16*)(a.ws + WS_P);
    {
        const int k = F.tid & 63, part = F.tid >> 6;
        const float lb = hgrn_lower(a.in[12], l, h * 64 + k);
        float lf[8], kk[8], qv[8]; float tot = 0.f;
#pragma unroll
        for (int i = 0; i < 8; ++i) { const size_t row = row0 + part * 8 + i;
            const float z = ZF[row * 256 + h * 64 + k]; const float f = fmaxf(lb + (1.f - lb) * fsigmoid(z), F_MIN);
            kk[i] = 1.f - f; lf[i] = __logf(f); tot += lf[i]; lf[i] = tot;
            qv[i] = fsilu(bf2f(P[row * DIN + 4 * 256 + h * 64 + k])); }
        PART[part * 64 + k] = tot;
        __syncthreads();
        float base = 0.f, r = 0.f;
#pragma unroll
        for (int p = 0; p < 8; ++p) { const float t = PART[p * 64 + k]; if (p < part) base += t; if (p < 4) r += t; }
        if (part == 0) ER[k] = __expf(r);
#pragma unroll
        for (int i = 0; i < 8; ++i) { const float bb = base + lf[i]; const int t = part * 8 + i;
            *(LAS bf16*)(QT + t * 144 + k * 2) = (bf16)f2bf(qv[i] * __expf(bb - r));
            *(LAS bf16*)(KT + t * 144 + k * 2) = (bf16)f2bf(kk[i] * __expf(r - bb)); }
    }
    {
        const int s = F.tid >> 3, v0 = (F.tid & 7) * 8;
        const v4u vv = *(const v4u*)(P + (row0 + s) * DIN + 6 * 256 + h * 64 + v0);
        const unsigned w[4] = {vv.x, vv.y, vv.z, vv.w};
#pragma unroll
        for (int j = 0; j < 4; ++j) { *(LAS bf16*)(VT + (v0 + 2 * j) * 144 + s * 2) = (bf16)(w[j] & 0xffffu); *(LAS bf16*)(VT + (v0 + 2 * j + 1) * 144 + s * 2) = (bf16)(w[j] >> 16); }
    }
    __syncthreads();
    {
        const int v = F.tid >> 3, k0 = (F.tid & 7) * 8;
        const float* S0 = (const float*)(a.ws + WS_S0) + ((size_t)(b * 4 + h) * NCH + c) * 4096 + v * 64 + k0;
        const f32x4 s0 = *(const f32x4*)S0, s1 = *(const f32x4*)(S0 + 4);
        v4u o; o.x = pk2(s0.x * ER[k0], s0.y * ER[k0 + 1]); o.y = pk2(s0.z * ER[k0 + 2], s0.w * ER[k0 + 3]); o.z = pk2(s1.x * ER[k0 + 4], s1.y * ER[k0 + 5]); o.w = pk2(s1.z * ER[k0 + 6], s1.w * ER[k0 + 7]);
        *(LAS v4u*)(ST + v * 144 + k0 * 2) = o;
    }
    f32x4 acc[2] = {(f32x4){0.f, 0.f, 0.f, 0.f}, (f32x4){0.f, 0.f, 0.f, 0.f}};
    mm64(QT, KT, acc, F.wave, F.lane);
    {   const int rs = F.wave >> 1, ch = F.wave & 1, fr = F.lane & 15, fq = F.lane >> 4;
#pragma unroll
        for (int nt = 0; nt < 2; ++nt)
#pragma unroll
            for (int e = 0; e < 4; ++e) { const int t = 16 * rs + 4 * fq + e, s = 32 * ch + 16 * nt + fr;
                *(LAS bf16*)(AM + t * 144 + s * 2) = (bf16)((s <= t) ? f2bf(acc[nt][e]) : 0u); }
    }
    __syncthreads();
    acc[0] = (f32x4){0.f, 0.f, 0.f, 0.f}; acc[1] = (f32x4){0.f, 0.f, 0.f, 0.f};
    mm64(AM, VT, acc, F.wave, F.lane);
    mm64(QT, ST, acc, F.wave, F.lane);
    {   const int rs = F.wave >> 1, ch = F.wave & 1, fr = F.lane & 15, fq = F.lane >> 4;
#pragma unroll
        for (int nt = 0; nt < 2; ++nt)
#pragma unroll
            for (int e = 0; e < 4; ++e) OF[(16 * rs + 4 * fq + e) * 65 + 32 * ch + 16 * nt + fr] = acc[nt][e];
    }
    __syncthreads();
    {
        const int t = F.tid >> 3, v0 = (F.tid & 7) * 8;
        float o[8]; float ss = 0.f;
#pragma unroll
        for (int j = 0; j < 8; ++j) { o[j] = OF[t * 65 + v0 + j]; ss += o[j] * o[j]; }
        ss += __shfl_xor(ss, 1); ss += __shfl_xor(ss, 2); ss += __shfl_xor(ss, 4);
        const float rsq = 1.0f / sqrtf(ss * (1.f / 64.f) + EPS);
        const v4u gv = *(const v4u*)(P + (row0 + t) * DIN + 7 * 256 + h * 64 + v0);
        const float* ng = a.in[13] + l * 256 + h * 64 + v0;
        const float g[8] = {bflo(gv.x), bfhi(gv.x), bflo(gv.y), bfhi(gv.y), bflo(gv.z), bfhi(gv.z), bflo(gv.w), bfhi(gv.w)};
        float y[8];
#pragma unroll
        for (int j = 0; j < 8; ++j) y[j] = o[j] * rsq * ng[j] * fsilu(g[j]);
        v4u w; w.x = pk2(y[0], y[1]); w.y = pk2(y[2], y[3]); w.z = pk2(y[4], y[5]); w.w = pk2(y[6], y[7]);
        *(GAS v4u*)((bf16*)(a.ws + WS_Y) + (row0 + t) * D + 512 + h * 64 + v0) = w;
    }
    __syncthreads();
}

__device__ __forceinline__ void hgrn_sample_unit(const Frame& F, const Args& a, int l, int unit) {
    const int b = unit >> 2, h = unit & 3, v = F.tid & 63, kg = F.tid >> 6;
    const size_t row0 = (size_t)MP + b * SS;
    LAS float* PT = (LAS float*)F.lds;
    const float* ZF = (const float*)(a.ws + WS_ZF); const bf16* P = (const bf16*)(a.ws + WS_P);
    const float* sin_ = a.in[4] + ((size_t)(b * DEPTH + l) * 4 + h) * 4096;
    float S[8], lb[8];
#pragma unroll
    for (int j = 0; j < 8; ++j) { S[j] = sin_[(kg * 8 + j) * 64 + v]; lb[j] = hgrn_lower(a.in[12], l, h * 64 + kg * 8 + j); }
#pragma unroll
    for (int t = 0; t < SS; ++t) {
        const size_t row = row0 + t;
        const float vt = bf2f(P[row * DIN + 6 * 256 + h * 64 + v]);
        const v4u qq = *(const v4u*)(P + row * DIN + 4 * 256 + h * 64 + kg * 8);
        const f32x4 z0 = *(const f32x4*)(ZF + row * 256 + h * 64 + kg * 8), z1 = *(const f32x4*)(ZF + row * 256 + h * 64 + kg * 8 + 4);
        const float z[8] = {z0.x, z0.y, z0.z, z0.w, z1.x, z1.y, z1.z, z1.w};
        const float q[8] = {bflo(qq.x), bfhi(qq.x), bflo(qq.y), bfhi(qq.y), bflo(qq.z), bfhi(qq.z), bflo(qq.w), bfhi(qq.w)};
        float op = 0.f;
#pragma unroll
        for (int j = 0; j < 8; ++j) { const float f = fmaxf(lb[j] + (1.f - lb[j]) * fsigmoid(z[j]), F_MIN); S[j] = f * S[j] + (1.f - f) * vt; op += S[j] * fsilu(q[j]); }
        PT[(t * 8 + kg) * 64 + v] = op;
    }
    float* sout = a.out + O_HGRNS + ((size_t)(b * DEPTH + l) * 4 + h) * 4096;
#pragma unroll
    for (int j = 0; j < 8; ++j) sout[(kg * 8 + j) * 64 + v] = S[j];
    __syncthreads();
    {
        const int t = F.wave; float o = 0.f;
#pragma unroll
        for (int g = 0; g < 8; ++g) o += PT[(t * 8 + g) * 64 + F.lane];
        const float rsq = 1.0f / sqrtf(wave_sum(o * o) * (1.f / 64.f) + EPS);
        const size_t row = row0 + t;
        const float gt = bf2f(P[row * DIN + 7 * 256 + h * 64 + F.lane]);
        const float y = o * rsq * a.in[13][l * 256 + h * 64 + F.lane] * fsilu(gt);
        ((bf16*)(a.ws + WS_Y))[row * D + 512 + h * 64 + F.lane] = (bf16)f2bf(y);
    }
    __syncthreads();
}

template <bool SAMPLE>
__device__ __forceinline__ void mix_abd_unit(const Frame& F, const Args& a, int l, int unit) {
    constexpr int SEG = SAMPLE ? 8 : 32, NT = SEG / 2, HR = 30;
    const size_t row0 = SAMPLE ? (size_t)MP + unit * SS : (size_t)unit * 32;
    const int tpos0 = SAMPLE ? 0 : (unit * 32) % PS;
    const int c = F.tid & 255, th = F.tid >> 8;
    LAS float* U = (LAS float*)F.lds;
    LAS float* CV = U + (HR + SEG) * 256;
    const bf16* P = (const bf16*)(a.ws + WS_P);
    bf16* Y = (bf16*)(a.ws + WS_Y);
#pragma unroll 2
    for (int i = th; i < HR + SEG; i += 2) {
        const int tau = i - HR; float u;
        if (tau >= 0 || (!SAMPLE && tpos0 + tau >= 0)) { const size_t row = row0 + tau; u = bf2f(P[row * DIN + 8 * 256 + c]) * fsigmoid(bf2f(P[row * DIN + 9 * 256 + c])); }
        else if (SAMPLE) u = a.in[5][((size_t)(unit * DEPTH + l) * 30 + (30 + tau)) * 256 + c];
        else u = 0.f;
        U[i * 256 + c] = u;
    }
    __syncthreads();
    {   float w[31], acc[NT];
#pragma unroll
        for (int j = 0; j < 31; ++j) w[j] = a.in[14][(size_t)(l * 31 + j) * 256 + c];
        const float bias = a.in[15][l * 256 + c];
#pragma unroll
        for (int o = 0; o < NT; ++o) acc[o] = bias;
#pragma unroll
        for (int ii = 0; ii < NT + 30; ++ii) { const float val = U[(th * NT + ii) * 256 + c];
#pragma unroll
            for (int o = 0; o < NT; ++o) { if (ii - o >= 0 && ii - o <= 30) acc[o] += w[ii - o] * val; } }
#pragma unroll
        for (int o = 0; o < NT; ++o) CV[(th * NT + o) * 256 + c] = acc[o];
    }
    {   const float w0 = a.in[9][(l * 3 + 0) * 256 + c], w1 = a.in[9][(l * 3 + 1) * 256 + c], w2 = a.in[9][(l * 3 + 2) * 256 + c];
        float vm2, vm1;
        {   const int t0 = th * NT;
            float hv[2];
#pragma unroll
            for (int j = 0; j < 2; ++j) { const int tau = t0 - 2 + j;
                if (tau >= 0 || (!SAMPLE && tpos0 + tau >= 0)) { const size_t row = row0 + tau; hv[j] = bf2f(P[row * DIN + 1 * 256 + c]) * bf2f(P[row * DIN + 2 * 256 + c]); }
                else if (SAMPLE) hv[j] = a.in[2][((size_t)(unit * DEPTH + l) * 2 + (2 + tau)) * 256 + c];
                else hv[j] = 0.f; }
            vm2 = hv[0]; vm1 = hv[1];
        }
#pragma unroll 4
        for (int o = 0; o < NT; ++o) { const size_t row = row0 + th * NT + o;
            const float v0 = bf2f(P[row * DIN + 1 * 256 + c]) * bf2f(P[row * DIN + 2 * 256 + c]);
            const float y = bf2f(P[row * DIN + c]) * (w0 * vm2 + w1 * vm1 + w2 * v0);
            Y[row * D + c] = (bf16)f2bf(y); vm2 = vm1; vm1 = v0; }
    }
    {   const int wlen = 2 << (c >> 6); const int t0 = th * NT;
        const float* hist = SAMPLE ? a.in[3] + ((size_t)(unit * DEPTH + l) * 15) * 256 + c : nullptr;
#define GETP(dst, tau_) do { const int _t = (tau_); if (_t >= 0 || (!SAMPLE && tpos0 + _t >= 0)) dst = bf2f(P[(row0 + _t) * DIN + 3 * 256 + c]); else if (SAMPLE) dst = hist[(15 + _t) * 256]; else dst = 0.f; } while (0)
        float s = 0.f;
        for (int j = 1; j < wlen; ++j) { float pv; GETP(pv, t0 - j); s += pv; }
#pragma unroll 4
        for (int o = 0; o < NT; ++o) { const int tau = t0 + o; float p0, pl; GETP(p0, tau); s += p0;
            const int cnt = SAMPLE ? wlen : min(tpos0 + tau + 1, wlen);
            Y[(row0 + tau) * D + 256 + c] = (bf16)f2bf(s / (float)cnt - p0);
            GETP(pl, tau - wlen + 1); s -= pl; }
#undef GETP
    }
    __syncthreads();
    {   const f32x4 lg = *((const GAS f32x4*)(a.in[16] + l * 256) + F.lane), lbv = *((const GAS f32x4*)(a.in[17] + l * 256) + F.lane);
        for (int t = F.wave; t < SEG; t += 8) {
            const f32x4 x = *(const LAS f32x4*)(CV + t * 256 + 4 * F.lane);
            const float mean = wave_sum((x.x + x.y) + (x.z + x.w)) * (1.f / 256.f);
            const f32x4 d = x - mean;
            const float var = wave_sum((d.x * d.x + d.y * d.y) + (d.z * d.z + d.w * d.w)) * (1.f / 256.f);
            const float rstd = 1.0f / sqrtf(var + EPS);
            const f32x4 y = d * rstd * lg + lbv;
            v2u w; w.x = pk2(fsilu(y.x), fsilu(y.y)); w.y = pk2(fsilu(y.z), fsilu(y.w));
            *((GAS v2u*)(Y + (row0 + t) * D + 768) + F.lane) = w;
        }
    }
    __syncthreads();
}

__device__ __forceinline__ void state_outputs(const Frame& F, const Args& a, int l) {
    const bf16* P = (const bf16*)(a.ws + WS_P);
    const int NTH = F.G * NWAVES * 64, gt = (F.vcu * NWAVES + F.wave) * 64 + F.lane;
    constexpr int NP = 8 * (2 + 15 + 30) * 256, NS = 128 * (2 + 15 + 30) * 256;
    for (int e = gt; e < NP + NS; e += NTH) {
        const bool smp = e >= NP; const int r = smp ? e - NP : e; const int c = r & 255, i47 = (r >> 8) % 47, b = (r >> 8) / 47;
        int kind, i; if (i47 < 2) { kind = 0; i = i47; } else if (i47 < 17) { kind = 1; i = i47 - 2; } else { kind = 2; i = i47 - 17; }
        const int len = kind == 0 ? 2 : (kind == 1 ? 15 : 30);
        float val;
        int tau;
        if (!smp) tau = PS - len + i; else tau = SS - len + i;
        if (tau >= 0) { const size_t row = smp ? (size_t)MP + b * SS + tau : (size_t)b * PS + tau;
            if (kind == 0) val = bf2f(P[row * DIN + 1 * 256 + c]) * bf2f(P[row * DIN + 2 * 256 + c]);
            else if (kind == 1) val = bf2f(P[row * DIN + 3 * 256 + c]);
            else val = bf2f(P[row * DIN + 8 * 256 + c]) * fsigmoid(bf2f(P[row * DIN + 9 * 256 + c]));
        } else { const float* src = kind == 0 ? a.in[2] : (kind == 1 ? a.in[3] : a.in[5]);
            val = src[((size_t)(b * DEPTH + l) * len + (len + tau)) * 256 + c]; }
        const size_t obase = smp ? (kind == 0 ? O_CONVS : (kind == 1 ? O_POOLS : O_CONFS)) : (kind == 0 ? O_CONVP : (kind == 1 ? O_POOLP : O_CONFP));
        a.out[obase + ((size_t)(b * DEPTH + l) * len + i) * 256 + c] = val;
    }
}

__device__ __forceinline__ void fold_rows(const Frame& F, const Args& a) {
    LAS float* scr = (LAS float*)(F.lds + F.wave * 16384);
    const int gw = F.vcu * NWAVES + F.wave, NGW = F.G * NWAVES;
    for (int it = gw; it < DEPTH * 4 * (D / 32); it += NGW) {
        const int l = it / (4 * (D / 32)), r = it % (4 * (D / 32)), kb = r / (D / 32), nb = r % (D / 32);
        wt_item((const float*)(a.ws + WS_WPF) + (size_t)l * 256 * D, D, 32 * nb, 64 * kb, w_out_t(a.ws, l), D, 32 * nb, 256 + 64 * kb, scr, F.lane);
    }
}

constexpr int N_PHASES = 1 + 8 * DEPTH;
constexpr int M2_UNITS = 1024 + 512 + 128 + 512;
__global__ void __launch_bounds__(NWAVES * 64, 2) mk_fwd(Args args) {
    extern __shared__ __attribute__((aligned(16))) unsigned char lds[];
    Frame F;
    F.lds = (LAS unsigned char*)lds;
    F.tid = threadIdx.x; F.lane = F.tid & 63; F.wave = __builtin_amdgcn_readfirstlane(F.tid >> 6);
    F.G = gridDim.x; { const int bx = blockIdx.x; F.vcu = (F.G % 8 == 0) ? (bx % 8) * (F.G / 8) + bx / 8 : bx; }
    volatile LAS unsigned* MISC = (volatile LAS unsigned*)(F.lds + MISC_OFF);
    for (int u = F.tid; u < 64; u += NWAVES * 64) MISC[u] = 0u;
    __syncthreads();
    unsigned char* ws = args.ws;
#if MK_N_LAUNCHES == 1
    XcdBarrier bar = xcd_barrier_post((unsigned*)(ws + WS_CTL) + CW_BAR, MISC + 8);
#define GRID_BAR() xcd_barrier(bar)
#else
#define GRID_BAR() do {} while (0)
#endif
    const int lo = args.ph_lo, hi = args.ph_hi;
#define IN(k) (lo <= (k) && (k) < hi)
#define SEAM(k) do { if (IN(k) && IN((k) + 1)) GRID_BAR(); } while (0)
    if (IN(0)) { phase0(F, args); } SEAM(0);
#define LAYER(l) \
    if (IN(1 + 8 * (l))) {            \
        pg8::Gemm g{(const bf16*)(ws + WS_XN), w_in_t(ws, l), M, DIN, D}; pg8::StaticOrder S; S.init(M, DIN, F.G, (int)blockIdx.x); \
        pg8::EpiP E{(bf16*)(ws + WS_P), (float*)(ws + WS_ZF)}; \
        pg8::gemm_phase<pg8::EpiP, pg8::StaticOrder, true, true>(F.lds, g, S, E); } SEAM(1 + 8 * (l)); \
    if (IN(2 + 8 * (l))) {            \
        if ((l) == 0) { fold_rows(F, args); __syncthreads(); } \
        for (int it = F.vcu; it < 256; it += F.G) hgrn_scan_unit(F, args, l, it); } SEAM(2 + 8 * (l)); \
    if (IN(3 + 8 * (l))) {            \
        for (int it = F.vcu; it < M2_UNITS; it += F.G) { \
            if (it < 1024) hgrn_out_unit(F, args, l, it); \
            else if (it < 1536) mix_abd_unit<false>(F, args, l, it - 1024); \
            else if (it < 1664) mix_abd_unit<true>(F, args, l, it - 1536); \
            else hgrn_sample_unit(F, args, l, it - 1664); } \
        state_outputs(F, args, l); } SEAM(3 + 8 * (l)); \
    if (IN(4 + 8 * (l))) {            \
        pg8::Gemm g{(const bf16*)(ws + WS_Y), w_out_t(ws, l), M, D, D}; pg8::StaticOrder S; S.init(M, D, F.G, (int)blockIdx.x); \
        pg8::EpiBf E{(bf16*)(ws + WS_MIX2), D}; \
        pg8::gemm_phase<pg8::EpiBf, pg8::StaticOrder, true, true>(F.lds, g, S, E); } SEAM(4 + 8 * (l)); \
    if (IN(5 + 8 * (l))) {            \
        phase_rows(F, args, (const bf16*)(ws + WS_MIX2), args.in[7] + (l) * D, args.in[19] + (l) * D); } SEAM(5 + 8 * (l)); \
    if (IN(6 + 8 * (l))) {            \
        pg8::Gemm g{(const bf16*)(ws + WS_XN), w_3_t(ws, l), M, 2 * DFF, D}; pg8::StaticOrder S; S.init(M, 2 * DFF, F.G, (int)blockIdx.x); \
        pg8::EpiAct E{(bf16*)(ws + WS_ACT), DFF}; \
        pg8::gemm_phase<pg8::EpiAct, pg8::StaticOrder, true, true>(F.lds, g, S, E); } SEAM(6 + 8 * (l)); \
    if (IN(7 + 8 * (l))) {            \
        pg8::Gemm g{(const bf16*)(ws + WS_ACT), w_dn_t(ws, l), M, D, DFF}; pg8::StaticOrder S; S.init(M, D, F.G, (int)blockIdx.x); \
        pg8::EpiBf E{(bf16*)(ws + WS_MIX4), D}; \
        pg8::gemm_phase<pg8::EpiBf, pg8::StaticOrder, true, true>(F.lds, g, S, E); } SEAM(7 + 8 * (l)); \
    if (IN(8 + 8 * (l))) {            \
        phase_rows(F, args, (const bf16*)(ws + WS_MIX4), args.in[20] + (l) * D, ((l) + 1 < DEPTH) ? args.in[6] + ((l) + 1) * D : nullptr); } SEAM(8 + 8 * (l));
    LAYER(0)
    LAYER(1)
#undef LAYER
#undef IN
#undef SEAM
}

extern "C" void kernel_launch(void* const* d_in, const int* in_sizes, int n_in, void* d_out, int out_size, void* d_ws, size_t ws_size, hipStream_t stream) {
    static int grid = 0;
    if (grid == 0) {
        if (n_in != 24 || out_size != (int)O_END || ws_size < WS_END) { fprintf(stderr, "kernel_launch: unexpected sizes n_in %d out %d ws %zu\n", n_in, out_size, ws_size); grid = -1; return; }
        int dev = 0, cus = 0;
        if (hipGetDevice(&dev) != hipSuccess || hipDeviceGetAttribute(&cus, hipDeviceAttributeMultiprocessorCount, dev) != hipSuccess) { grid = -1; return; }
        if (hipFuncSetAttribute((const void*)mk_fwd, hipFuncAttributeMaxDynamicSharedMemorySize, LDS_BYTES) != hipSuccess) { fprintf(stderr, "kernel_launch: hipFuncSetAttribute failed\n"); grid = -1; return; }
        int per_cu = 0;
        if (hipOccupancyMaxActiveBlocksPerMultiprocessor(&per_cu, (const void*)mk_fwd, NWAVES * 64, LDS_BYTES) != hipSuccess || per_cu < 1) fprintf(stderr, "kernel_launch: occupancy query says %d\n", per_cu);
        (void)hipGetLastError();
        grid = cus;
    }
    if (grid < 0) return;
    if (hipMemsetAsync((char*)d_ws + WS_CTL, 0, CTL_ZERO_BYTES, stream) != hipSuccess) return;
    Args a{};
    for (int i = 0; i < 24; ++i) a.in[i] = (const float*)d_in[i];
    a.out = (float*)d_out; a.ws = (unsigned char*)d_ws;
#if MK_N_LAUNCHES == 1
    a.ph_lo = 0; a.ph_hi = N_PHASES; a.li = 0;
    hipLaunchKernelGGL(mk_fwd, dim3(grid), dim3(NWAVES * 64), LDS_BYTES, stream, a);
#else
    for (int ph = 0; ph < N_PHASES; ++ph) { a.ph_lo = ph; a.ph_hi = ph + 1; a.li = ph;
        hipLaunchKernelGGL(mk_fwd, dim3(grid), dim3(NWAVES * 64), LDS_BYTES, stream, a); }
#endif
}
```

```cpp
#include <hip/hip_runtime.h>
#include <cstdio>
#include <cstdint>

namespace pg8 {
#define PG8_LAS __attribute__((address_space(3)))
typedef unsigned short bf16_t;
typedef short bf16x8 __attribute__((ext_vector_type(8)));
typedef float f32x4 __attribute__((ext_vector_type(4)));
typedef unsigned u32x4 __attribute__((ext_vector_type(4)));
constexpr int BM = 256, BK = 64, HALF = 128, HTB = HALF * BK * 2  , STAGE_BYTES = 8 * HTB, NXCD = 8, WGM = 8;

__host__ __device__ __forceinline__ int lds_byte(int r, int c) { const int st = (r >> 4) * 2 + (c >> 5), rr = r & 15, cc = c & 31, ob = rr * 64 + cc * 2; return st * 1024 + (ob ^ (((ob >> 9) & 1) << 5)); }
__host__ __device__ __forceinline__ void stage_rc(int b, int& R, int& C) { const int st = b / 1024, sb = b % 1024, swz = sb ^ (((sb >> 9) & 1) << 5); R = (st >> 1) * 16 + swz / 64; C = (st & 1) * 32 + (swz % 64) / 2; }
__host__ __device__ __forceinline__ int perm32(int rho) { const int n = rho >> 4, i = rho & 15; return 8 * (i >> 2) + 4 * n + (i & 3); }

struct Unit { int pm, pn; };
struct Gemm { const bf16_t* A; const bf16_t* Bt; int M, N, K; };

struct StaticOrder {
    int nM, nN, nwg, G, c;
    __host__ __device__ void init(int M, int N, int G_, int c_) { nM = M / BM; nN = N / BM; nwg = nM * nN; G = G_; c = c_; }
    __host__ __device__ bool next(int i, Unit& u) const {
        const long L = (long)i * G + c; if (L >= nwg) return false;
        int wgid = (int)L; { const int q = nwg / NXCD, r = nwg % NXCD, xcd = wgid % NXCD, off = wgid / NXCD; wgid = (xcd < r ? xcd * (q + 1) : r * (q + 1) + (xcd - r) * q) + off; }
        const int nig = WGM * nN, gid = wgid / nig, fm = gid * WGM, gsz = (nM - fm) < WGM ? (nM - fm) : WGM;
        u.pm = fm + ((wgid % nig) % gsz); u.pn = (wgid % nig) / gsz; return true;
    }
    __device__ __forceinline__ void a_ready(const Unit&) const {}
    __device__ __forceinline__ void done(const Unit&) const {}
};

__device__ __forceinline__ unsigned cvt_pk_bf16(float lo, float hi) { unsigned r; asm volatile("v_cvt_pk_bf16_f32 %0, %1, %2" : "=v"(r) : "v"(lo), "v"(hi)); return r; }
__device__ __forceinline__ float fsigmoid(float x) { return __builtin_amdgcn_rcpf(1.0f + __expf(-x)); }
__device__ __forceinline__ float fsilu(float x) { return x * fsigmoid(x); }

struct EpiP2 {
    static constexpr bool PERM = true, AFTER_DRAIN = false;
    bf16_t* P; float* ZF; const float* lbw; int layer;
    __device__ __forceinline__ void operator()(const f32x4 (&acc)[2][2][4][2], const Unit& u, int wr, int wc, int fr, int fq) const {
        const int row0 = u.pm * BM + wr * 64 + fr, colw = wc * 32 + 8 * fq, pn = u.pn;
        if (pn == 5) {
            float lb[2][8];
#pragma unroll
            for (int bj = 0; bj < 2; ++bj)
#pragma unroll
                for (int j = 0; j < 8; ++j) { const int c = bj * HALF + colw + j;
                    if (layer == 0) lb[bj][j] = 0.f; else { const float a0 = lbw[c], a1 = lbw[256 + c], mx = fmaxf(a0, a1), e0 = __expf(a0 - mx), e1 = __expf(a1 - mx); lb[bj][j] = e1 / (e0 + e1); } }
#pragma unroll
            for (int ai = 0; ai < 2; ++ai)
#pragma unroll
                for (int m = 0; m < 4; ++m) { float* rowp = ZF + (size_t)(row0 + ai * HALF + m * 16) * 256 + colw;
#pragma unroll
                    for (int bj = 0; bj < 2; ++bj) { f32x4 f0, f1;
#pragma unroll
                        for (int j = 0; j < 4; ++j) { f0[j] = fmaxf(lb[bj][j] + (1.f - lb[bj][j]) * fsigmoid(acc[ai][bj][m][0][j]), 1e-20f); f1[j] = fmaxf(lb[bj][4 + j] + (1.f - lb[bj][4 + j]) * fsigmoid(acc[ai][bj][m][1][j]), 1e-20f); }
                        *(f32x4*)(rowp + bj * HALF) = f0; *(f32x4*)(rowp + bj * HALF + 4) = f1; } }
        } else if (pn == 1 || pn == 2 || pn >= 8) {
            const int cbase = (pn >= 8 ? 6 * 256 + (pn - 8) * HALF : 256 + (pn - 1) * HALF) + colw; const bool glu = pn >= 8;
#pragma unroll
            for (int ai = 0; ai < 2; ++ai)
#pragma unroll
                for (int m = 0; m < 4; ++m) { bf16_t* rowp = P + (size_t)(row0 + ai * HALF + m * 16) * 1792 + cbase;
                    const f32x4 a0 = acc[ai][0][m][0], a1 = acc[ai][0][m][1], b0 = acc[ai][1][m][0], b1 = acc[ai][1][m][1]; f32x4 r0, r1;
#pragma unroll
                    for (int j = 0; j < 4; ++j) { r0[j] = a0[j] * (glu ? fsigmoid(b0[j]) : b0[j]); r1[j] = a1[j] * (glu ? fsigmoid(b1[j]) : b1[j]); }
                    u32x4 w; w.x = cvt_pk_bf16(r0[0], r0[1]); w.y = cvt_pk_bf16(r0[2], r0[3]); w.z = cvt_pk_bf16(r1[0], r1[1]); w.w = cvt_pk_bf16(r1[2], r1[3]);
                    *(u32x4*)rowp = w; }
        } else {
            const int blk = pn == 0 ? 0 : (pn == 3 ? 2 : (pn == 4 ? 3 : (pn == 6 ? 4 : 5))); const bool act = (pn == 4 || pn == 7);
#pragma unroll
            for (int ai = 0; ai < 2; ++ai)
#pragma unroll
                for (int m = 0; m < 4; ++m) { bf16_t* rowp = P + (size_t)(row0 + ai * HALF + m * 16) * 1792 + blk * 256 + colw;
#pragma unroll
                    for (int bj = 0; bj < 2; ++bj) { f32x4 v0 = acc[ai][bj][m][0], v1 = acc[ai][bj][m][1];
                        if (act) {
#pragma unroll
                            for (int j = 0; j < 4; ++j) { v0[j] = fsilu(v0[j]); v1[j] = fsilu(v1[j]); } }
                        u32x4 w; w.x = cvt_pk_bf16(v0[0], v0[1]); w.y = cvt_pk_bf16(v0[2], v0[3]); w.z = cvt_pk_bf16(v1[0], v1[1]); w.w = cvt_pk_bf16(v1[2], v1[3]);
                        *(u32x4*)(rowp + bj * HALF) = w; } }
        }
    }
};
struct EpiBf {
    static constexpr bool PERM = true, AFTER_DRAIN = false;
    bf16_t* O; int ldc;
    __device__ __forceinline__ void operator()(const f32x4 (&acc)[2][2][4][2], const Unit& u, int wr, int wc, int fr, int fq) const {
        const int row0 = u.pm * BM + wr * 64 + fr, col0 = u.pn * BM + wc * 32 + 8 * fq;
#pragma unroll
        for (int ai = 0; ai < 2; ++ai)
#pragma unroll
            for (int m = 0; m < 4; ++m) { bf16_t* rowp = O + (size_t)(row0 + ai * HALF + m * 16) * ldc + col0;
#pragma unroll
                for (int bj = 0; bj < 2; ++bj) { const f32x4 v0 = acc[ai][bj][m][0], v1 = acc[ai][bj][m][1];
                    u32x4 w; w.x = cvt_pk_bf16(v0[0], v0[1]); w.y = cvt_pk_bf16(v0[2], v0[3]); w.z = cvt_pk_bf16(v1[0], v1[1]); w.w = cvt_pk_bf16(v1[2], v1[3]);
                    *(u32x4*)(rowp + bj * HALF) = w; } }
    }
};
struct EpiAct {
    static constexpr bool PERM = true, AFTER_DRAIN = false;
    bf16_t* O; int ldc;
    __device__ __forceinline__ void operator()(const f32x4 (&acc)[2][2][4][2], const Unit& u, int wr, int wc, int fr, int fq) const {
        const int row0 = u.pm * BM + wr * 64 + fr, col0 = u.pn * HALF + wc * 32 + 8 * fq;
#pragma unroll
        for (int ai = 0; ai < 2; ++ai)
#pragma unroll
            for (int m = 0; m < 4; ++m) { bf16_t* rowp = O + (size_t)(row0 + ai * HALF + m * 16) * ldc + col0;
                f32x4 r0, r1; const f32x4 g0 = acc[ai][0][m][0], g1 = acc[ai][0][m][1], u0 = acc[ai][1][m][0], u1 = acc[ai][1][m][1];
#pragma unroll
                for (int j = 0; j < 4; ++j) { r0[j] = fsilu(g0[j]) * u0[j]; r1[j] = fsilu(g1[j]) * u1[j]; }
                u32x4 w; w.x = cvt_pk_bf16(r0[0], r0[1]); w.y = cvt_pk_bf16(r0[2], r0[3]); w.z = cvt_pk_bf16(r1[0], r1[1]); w.w = cvt_pk_bf16(r1[2], r1[3]);
                *(u32x4*)rowp = w; }
    }
};

template <class Epi, class Sched, bool ALIGN_EPI = false, bool SP2 = false>
__device__ __forceinline__ void gemm_phase(PG8_LAS unsigned char* lds, const Gemm g, const Sched& S, const Epi& E) {
    const int tid = threadIdx.x, wid = __builtin_amdgcn_readfirstlane(tid >> 6), lane = tid & 63, wr = wid >> 2, wc = wid & 3, fr = lane & 15, fq = lane >> 4;
    const int K = g.K, nt = K / BK;
    unsigned voffA[2], voffB[2];
#pragma unroll
    for (int i = 0; i < 2; ++i) { int R, C; stage_rc(tid * 16 + i * 8192, R, C); const int Rb = Epi::PERM ? ((R & ~31) + perm32(R & 31)) : R;
        voffA[i] = (unsigned)(R * K + C) * 2u; voffB[i] = (unsigned)(Rb * K + C) * 2u; }
    const size_t kstep = (size_t)(BK * 2);
    const size_t hstep = (size_t)HALF * K * 2;
    const size_t tstep = 2 * hstep;
    const unsigned ldsw = (unsigned)wid * 1024u;
    const int aoff = lds_byte(wr * 64 + fr, fq * 8), boff = lds_byte(wc * 32 + fr, fq * 8);
#define PG8_SA(b, h) (((b) * 2 + (h)) * HTB)
#define PG8_SB(b, h) ((4 + (b) * 2 + (h)) * HTB)
#define PG8_STAGE(bufoff, gbase, voff) do { _Pragma("unroll") for (int _i = 0; _i < 2; ++_i) \
        __builtin_amdgcn_global_load_lds((const unsigned*)((const char*)(gbase) + (voff)[_i]), (PG8_LAS unsigned*)(lds + (bufoff) + ldsw + _i * 8192), 16, 0, 0); } while (0)
#define PG8_LDA(dst, b, h) do { _Pragma("unroll") for (int m = 0; m < 4; ++m) _Pragma("unroll") for (int k = 0; k < 2; ++k) dst[m][k] = *(const PG8_LAS bf16x8*)(lds + PG8_SA(b, h) + aoff + m * 2048 + k * 1024); } while (0)
#define PG8_LDB(dst, b, h) do { _Pragma("unroll") for (int n = 0; n < 2; ++n) _Pragma("unroll") for (int k = 0; k < 2; ++k) dst[n][k] = *(const PG8_LAS bf16x8*)(lds + PG8_SB(b, h) + boff + n * 2048 + k * 1024); } while (0)
#define PG8_MMA(ai, bj, At, Bt) do { __builtin_amdgcn_s_setprio(1); _Pragma("unroll") for (int m = 0; m < 4; ++m) _Pragma("unroll") for (int n = 0; n < 2; ++n) _Pragma("unroll") for (int k = 0; k < 2; ++k) \
        acc[ai][bj][m][n] = __builtin_amdgcn_mfma_f32_16x16x32_bf16(Bt[n][k], At[m][k], acc[ai][bj][m][n], 0, 0, 0); __builtin_amdgcn_s_setprio(0); } while (0)
#define PG8_WAIT_V(n) asm volatile("s_waitcnt vmcnt(" #n ")" ::: "memory")
#define PG8_WAIT_L(n) asm volatile("s_waitcnt lgkmcnt(" #n ")" ::: "memory")
#define PG8_BAR __builtin_amdgcn_s_barrier()
#define PG8_SCHED __builtin_amdgcn_sched_barrier(0)
    Unit cur, nxt; int ui = 0;
    if (!S.next(0, cur)) return;
    f32x4 acc[2][2][4][2];
#pragma unroll
    for (int a = 0; a < 2; ++a)
#pragma unroll
        for (int b = 0; b < 2; ++b)
#pragma unroll
            for (int m = 0; m < 4; ++m)
#pragma unroll
                for (int n = 0; n < 2; ++n) acc[a][b][m][n] = (f32x4){0.f, 0.f, 0.f, 0.f};
    bf16x8 At[4][2], B0[2][2], B1[2][2];
    const char* cA = (const char*)g.A + (size_t)cur.pm * tstep; const char* cB = (const char*)g.Bt + (size_t)cur.pn * tstep;
    S.a_ready(cur);
    if constexpr (SP2) {
        PG8_STAGE(PG8_SB(0, 0), cB, voffB); PG8_STAGE(PG8_SB(0, 1), cB + hstep, voffB); PG8_STAGE(PG8_SA(0, 0), cA, voffA); PG8_STAGE(PG8_SA(0, 1), cA + hstep, voffA);
        if (wr == 1) PG8_BAR;
        PG8_WAIT_V(2); PG8_BAR;
        PG8_STAGE(PG8_SB(1, 0), cB + kstep, voffB); PG8_STAGE(PG8_SA(1, 0), cA + kstep, voffA); PG8_STAGE(PG8_SB(1, 1), cB + hstep + kstep, voffB);
        PG8_WAIT_V(6); PG8_BAR;
    } else {
        PG8_STAGE(PG8_SB(0, 0), cB, voffB); PG8_STAGE(PG8_SA(0, 0), cA, voffA); PG8_STAGE(PG8_SB(0, 1), cB + hstep, voffB); PG8_STAGE(PG8_SA(0, 1), cA + hstep, voffA);
        if (wr == 1) PG8_BAR;
        PG8_WAIT_V(4); PG8_BAR;
        PG8_STAGE(PG8_SB(1, 0), cB + kstep, voffB); PG8_STAGE(PG8_SA(1, 0), cA + kstep, voffA); PG8_STAGE(PG8_SB(1, 1), cB + hstep + kstep, voffB);
        PG8_WAIT_V(6); PG8_BAR;
    }
    for (;;) {
        const bool has_next = S.next(ui + 1, nxt);
        const char* nA = has_next ? (const char*)g.A + (size_t)nxt.pm * tstep : cA; const char* nB = has_next ? (const char*)g.Bt + (size_t)nxt.pn * tstep : cB;
        for (int t = 0; t < nt; t += 2) {
            const bool last = (t == nt - 2);
            const char* a1 = cA + (size_t)(t + 1) * kstep;
            const char* a2 = last ? nA : cA + (size_t)(t + 2) * kstep; const char* b2 = last ? nB : cB + (size_t)(t + 2) * kstep;
            const char* a3 = a2 + kstep; const char* b3 = b2 + kstep;
            if (last && has_next) S.a_ready(nxt);
            if constexpr (SP2) {
            PG8_LDB(B0, 0, 0); PG8_LDB(B1, 0, 1); PG8_SCHED; PG8_LDA(At, 0, 0); PG8_STAGE(PG8_SA(1, 1), a1 + hstep, voffA);
            PG8_WAIT_V(8); PG8_WAIT_L(0); PG8_BAR; PG8_MMA(0, 0, At, B0); PG8_MMA(0, 1, At, B1); PG8_BAR; PG8_SCHED;
            PG8_LDA(At, 0, 1); PG8_STAGE(PG8_SB(0, 0), b2, voffB); PG8_STAGE(PG8_SB(0, 1), b2 + hstep, voffB); PG8_STAGE(PG8_SA(0, 0), a2, voffA);
            PG8_WAIT_V(8); PG8_WAIT_L(0); PG8_BAR; PG8_MMA(1, 0, At, B0); PG8_MMA(1, 1, At, B1); PG8_BAR; PG8_SCHED;
            PG8_LDB(B0, 1, 0); PG8_LDB(B1, 1, 1); PG8_SCHED; PG8_LDA(At, 1, 0); PG8_STAGE(PG8_SA(0, 1), a2 + hstep, voffA);
            PG8_WAIT_V(8); PG8_WAIT_L(0); PG8_BAR; PG8_MMA(0, 0, At, B0); PG8_MMA(0, 1, At, B1); PG8_BAR; PG8_SCHED;
            PG8_LDA(At, 1, 1); PG8_STAGE(PG8_SB(1, 0), b3, voffB); PG8_STAGE(PG8_SB(1, 1), b3 + hstep, voffB); PG8_STAGE(PG8_SA(1, 0), a3, voffA);
            PG8_WAIT_V(8); PG8_WAIT_L(0); PG8_BAR; PG8_MMA(1, 0, At, B0); PG8_MMA(1, 1, At, B1); PG8_BAR; PG8_SCHED;
            } else {
            PG8_LDB(B0, 0, 0); PG8_SCHED; PG8_LDA(At, 0, 0); PG8_STAGE(PG8_SA(1, 1), a1 + hstep, voffA);
            PG8_WAIT_L(8); PG8_BAR; PG8_WAIT_L(0); PG8_MMA(0, 0, At, B0); PG8_BAR; PG8_SCHED;
            PG8_LDB(B1, 0, 1); PG8_STAGE(PG8_SB(0, 0), b2, voffB);
            PG8_BAR; PG8_WAIT_L(0); PG8_MMA(0, 1, At, B1); PG8_BAR;
            PG8_LDA(At, 0, 1); PG8_STAGE(PG8_SA(0, 0), a2, voffA);
            PG8_BAR; PG8_WAIT_L(0); PG8_MMA(1, 0, At, B0); PG8_BAR; PG8_SCHED;
            PG8_STAGE(PG8_SB(0, 1), b2 + hstep, voffB);
            PG8_WAIT_V(6); PG8_BAR; PG8_MMA(1, 1, At, B1); PG8_BAR;
            PG8_LDB(B0, 1, 0); PG8_SCHED; PG8_LDA(At, 1, 0); PG8_STAGE(PG8_SA(0, 1), a2 + hstep, voffA);
            PG8_WAIT_L(8); PG8_BAR; PG8_WAIT_L(0); PG8_MMA(0, 0, At, B0); PG8_BAR; PG8_SCHED;
            PG8_LDB(B1, 1, 1); PG8_STAGE(PG8_SB(1, 0), b3, voffB);
            PG8_BAR; PG8_WAIT_L(0); PG8_MMA(0, 1, At, B1); PG8_BAR;
            PG8_LDA(At, 1, 1); PG8_STAGE(PG8_SA(1, 0), a3, voffA);
            PG8_BAR; PG8_WAIT_L(0); PG8_MMA(1, 0, At, B0); PG8_BAR; PG8_SCHED;
            PG8_STAGE(PG8_SB(1, 1), b3 + hstep, voffB);
            PG8_WAIT_V(6); PG8_BAR; PG8_MMA(1, 1, At, B1); PG8_BAR;
            }
        }
        if constexpr (ALIGN_EPI) { if (wr == 0) PG8_BAR; }
        if constexpr (!Epi::AFTER_DRAIN) { E(acc, cur, wr, wc, fr, fq); S.done(cur); }
        if (!has_next) break;
#pragma unroll
        for (int a = 0; a < 2; ++a)
#pragma unroll
            for (int b = 0; b < 2; ++b)
#pragma unroll
                for (int m = 0; m < 4; ++m)
#pragma unroll
                    for (int n = 0; n < 2; ++n) acc[a][b][m][n] = (f32x4){0.f, 0.f, 0.f, 0.f};
        cur = nxt; cA = nA; cB = nB; ++ui;
        if constexpr (ALIGN_EPI) { if (wr == 1) PG8_BAR; }
    }
    PG8_WAIT_V(0);
    if constexpr (!ALIGN_EPI) { if (wr == 0) PG8_BAR; }
    PG8_BAR;
    if constexpr (Epi::AFTER_DRAIN) { E.fused(acc, cur, wr, wc, fr, fq, lds, wid, lane); S.done(cur); }
#undef PG8_SA
#undef PG8_SB
#undef PG8_STAGE
#undef PG8_LDA
#undef PG8_LDB
#undef PG8_MMA
#undef PG8_WAIT_V
#undef PG8_WAIT_L
#undef PG8_BAR
#undef PG8_SCHED
}
}

#ifndef MK_N_LAUNCHES
#define MK_N_LAUNCHES 1
#endif

constexpr int NWAVES = 8;
constexpr int D = 1024, DEPTH = 2, G4 = 256, DIN = 2560, DFF = 2816, PW = 1792;
constexpr int PB = 8, PS = 2048, SB = 128, SS = 8;
constexpr int MP = PB * PS;
constexpr int MS = SB * SS;
constexpr int M = MP + MS;
constexpr float EPS = 1e-6f, F_MIN = 1e-20f;
constexpr int NCH = PS / 64;

constexpr size_t O_Y = 0, O_CONVP = (size_t)M * D, O_POOLP = O_CONVP + 8 * 2 * 2 * 256, O_HGRNP = O_POOLP + 8 * 2 * 15 * 256, O_CONFP = O_HGRNP + 8 * 2 * 4 * 64 * 64,
                 O_CONVS = O_CONFP + 8 * 2 * 30 * 256, O_POOLS = O_CONVS + 128 * 2 * 2 * 256, O_HGRNS = O_POOLS + 128 * 2 * 15 * 256, O_CONFS = O_HGRNS + (size_t)128 * 2 * 4 * 64 * 64,
                 O_END = O_CONFS + 128 * 2 * 30 * 256;
static_assert(O_END == 25554944, "output size");

constexpr size_t MiB = 1u << 20;
constexpr size_t WS_CTL = 0, CTL_ZERO_BYTES = 1 * MiB;
constexpr size_t SZ_WIN = (size_t)DIN * D * 2, SZ_WOUT = (size_t)D * D * 2, SZ_W3 = (size_t)2 * DFF * D * 2, SZ_WDN = (size_t)D * DFF * 2, SZ_WL = SZ_WIN + SZ_WOUT + SZ_W3 + SZ_WDN;
constexpr size_t WS_W = 1 * MiB;
constexpr size_t WS_WPF = WS_W + 2 * SZ_WL;
constexpr size_t WS_XN = WS_WPF + 2 * MiB;
constexpr size_t WS_Y = WS_XN + (size_t)M * D * 2;
constexpr size_t WS_S0 = WS_Y + (size_t)M * D * 2;
constexpr size_t WS_R = WS_S0 + (size_t)8 * 4 * NCH * 4096 * 4;
constexpr size_t WS_P = WS_R, WS_ZF = WS_P + (size_t)M * PW * 2, WS_ACT = WS_R, WS_MIX2 = WS_R, WS_MIX4 = WS_Y;
constexpr size_t WS_END = WS_R + (size_t)M * DFF * 2;
static_assert(WS_ZF + (size_t)M * 256 * 4 <= WS_END, "P | ZF fit the shared region");
static_assert(WS_END <= 256 * MiB, "d_ws map");
static_assert((size_t)M * DFF * 2 <= WS_END - WS_R, "ACT fits the shared region");

constexpr int CW_TMO = 0, CW_CODE = 1, CW_BAR = 4096;

constexpr int RING_BYTES = 131072;
constexpr int LDS_BYTES = 147456;
constexpr int MISC_OFF = LDS_BYTES - 256;

#define GAS __attribute__((address_space(1)))
#define LAS __attribute__((address_space(3)))
typedef unsigned short bf16;
typedef unsigned v4u __attribute__((ext_vector_type(4)));
typedef unsigned v2u __attribute__((ext_vector_type(2)));
typedef float f32x4 __attribute__((ext_vector_type(4)));
typedef short bf16x8 __attribute__((ext_vector_type(8)));
typedef GAS unsigned gu32;
#define RLX_AGENT __ATOMIC_RELAXED, __HIP_MEMORY_SCOPE_AGENT
#define LDS_WAIT() asm volatile("s_waitcnt lgkmcnt(0)" ::: "memory")
#define VM_WAIT() asm volatile("s_waitcnt vmcnt(0)" ::: "memory")
__device__ __forceinline__ unsigned f2bf(float f) { unsigned u = __builtin_bit_cast(unsigned, f); return (u + 0x7fffu + ((u >> 16) & 1u)) >> 16; }
__device__ __forceinline__ unsigned pk2(float lo, float hi) { return f2bf(lo) | (f2bf(hi) << 16); }
__device__ __forceinline__ float bf2f(unsigned h) { return __builtin_bit_cast(float, h << 16); }
__device__ __forceinline__ float bflo(unsigned w) { return __builtin_bit_cast(float, w << 16); }
__device__ __forceinline__ float bfhi(unsigned w) { return __builtin_bit_cast(float, w & 0xffff0000u); }
using pg8::fsigmoid; using pg8::fsilu;

#define XB_TMO      128
#define XB_XCNT(j)  (256  + 64 * (j))
#define XB_XSUB(j)  (1280 + 64 * (j))
#define XB_XGEN(j)  (2304 + 64 * (j))
#define XB_TOP      3328
#define XB_TOPGEN   3392
#define XCD_BAR_WORDS 3456
#define XB_SPIN_CAP (1u << 18)

__device__ __forceinline__ unsigned xb_ld(unsigned* p)              { return __hip_atomic_load(p, __ATOMIC_RELAXED, __HIP_MEMORY_SCOPE_AGENT); }
__device__ __forceinline__ unsigned xb_add(unsigned* p, unsigned v) { return __hip_atomic_fetch_add(p, v, __ATOMIC_RELAXED, __HIP_MEMORY_SCOPE_AGENT); }
__device__ __forceinline__ unsigned xb_xcc_id() { return (unsigned)__builtin_amdgcn_s_getreg((3 << 11) | 20) & 0xFu; }
#define XB_SPIN(cond, bar) do { unsigned _sp = 0; while (cond) { __builtin_amdgcn_s_sleep(1); \
    if ((++_sp & 255u) == 0u) { if (xb_ld(&(bar)[XB_TMO])) break; if (_sp > XB_SPIN_CAP) { atomicAdd(&(bar)[XB_TMO], 1u); break; } } } } while (0)

struct XcdBarrier {
    unsigned* bar; unsigned x;
    volatile LAS unsigned* st;
};

__device__ __forceinline__ XcdBarrier xcd_barrier_post(unsigned* bar, volatile LAS unsigned* st) {
    XcdBarrier b; b.bar = bar; b.x = xb_xcc_id(); b.st = st;
    if (threadIdx.x == 0) (void)xb_add(&bar[XB_XCNT(b.x)], 1u);
    return b;
}
__device__ __forceinline__ void xcd_barrier_complete(unsigned* bar, unsigned x, unsigned& nloc, unsigned& nx) {
    const unsigned G = gridDim.x * gridDim.y * gridDim.z;
    unsigned sum, cnt, mine, sp = 0u;
    for (;;) {
        sum = 0u; cnt = 0u; mine = 0u;
#pragma unroll
        for (unsigned j = 0; j < 16; ++j) { const unsigned c = xb_ld(&bar[XB_XCNT(j)]); sum += c; cnt += (c > 0u) ? 1u : 0u; mine = (j == x) ? c : mine; }
        if (sum == G) break;
        __builtin_amdgcn_s_sleep(1);
        if ((++sp & 255u) == 0u) { if (xb_ld(&bar[XB_TMO])) break; if (sp > XB_SPIN_CAP) { atomicAdd(&bar[XB_TMO], 1u); break; } }
    }
    nloc = mine > 0u ? mine : 1u; nx = cnt > 0u ? cnt : 1u;
}

__device__ __forceinline__ void xcd_barrier(const XcdBarrier& b) {
    asm volatile("s_waitcnt vmcnt(0)" ::: "memory");
    __syncthreads();
    if (threadIdx.x == 0) {
        unsigned* bar = b.bar;
        __builtin_amdgcn_s_waitcnt(0);
        unsigned nloc = b.st[0], nx = b.st[1];
        if (nloc == 0u) { xcd_barrier_complete(bar, b.x, nloc, nx); b.st[0] = nloc; b.st[1] = nx; }
        const unsigned old = xb_add(&bar[XB_XSUB(b.x)], 1u);
        const unsigned gen = old / nloc;
        if (old + 1u == (gen + 1u) * nloc) {
            __builtin_amdgcn_fence(__ATOMIC_RELEASE, "agent");
            asm volatile("s_waitcnt vmcnt(0)" ::: "memory");
            const unsigned og = xb_add(&bar[XB_TOP], 1u);
            const unsigned tg = og / nx;
            if (og + 1u == (tg + 1u) * nx) xb_add(&bar[XB_TOPGEN], 1u);
            else XB_SPIN(xb_ld(&bar[XB_TOPGEN]) == tg, bar);
            __builtin_amdgcn_fence(__ATOMIC_ACQUIRE, "agent");
            xb_add(&bar[XB_XGEN(b.x)], 1u);
            asm volatile("s_waitcnt vmcnt(0)" ::: "memory");
        } else {
            XB_SPIN(xb_ld(&bar[XB_XGEN(b.x)]) == gen, bar);
            __builtin_amdgcn_fence(__ATOMIC_ACQUIRE, "agent");
            asm volatile("s_waitcnt vmcnt(0)" ::: "memory");
        }
    }
    __syncthreads();
}

struct Args { const float* in[24]; float* out; unsigned char* ws; int ph_lo, ph_hi, li, pad; };
struct Frame {
    LAS unsigned char* lds;
    int tid, lane, wave, vcu, G;
};
__device__ __forceinline__ float wave_sum(float v) {
#pragma unroll
    for (int o = 1; o < 64; o <<= 1) v += __shfl_xor(v, o);
    return v;
}

__device__ __forceinline__ void wt_item(const float* W, int ldw, int col0, int ksrc0, bf16* WT, int K, int out_row0, int kdst0, LAS float* scr, int lane) {
#pragma unroll 8
    for (int i = 0; i < 32; ++i) { const int kk = 2 * i + (lane >> 5); scr[kk * 33 + (lane & 31)] = W[(size_t)(ksrc0 + kk) * ldw + col0 + (lane & 31)]; }
    LDS_WAIT(); asm volatile("" ::: "memory");
    const int c = lane & 7;
#pragma unroll
    for (int j = 0; j < 4; ++j) { const int n = (lane >> 3) + 8 * j; const LAS float* s = scr + (8 * c) * 33 + n;
        v4u o; o.x = pk2(s[0 * 33], s[1 * 33]); o.y = pk2(s[2 * 33], s[3 * 33]); o.z = pk2(s[4 * 33], s[5 * 33]); o.w = pk2(s[6 * 33], s[7 * 33]);
        *(GAS v4u*)(WT + (size_t)(out_row0 + n) * K + kdst0 + 8 * c) = o; }
    LDS_WAIT(); asm volatile("" ::: "memory");
}
constexpr int IT_WIN = (D / 64) * (DIN / 32);
constexpr int IT_WOUT = (D / 64) * (D / 32);
constexpr int IT_W3 = (D / 64) * (2 * DFF / 32);
constexpr int IT_WDN = (DFF / 64) * (D / 32);
constexpr int IT_LAYER = IT_WIN + IT_WOUT + IT_W3 + IT_WDN;
__device__ __forceinline__ bf16* w_in_t(unsigned char* ws, int l) { return (bf16*)(ws + WS_W + (size_t)l * SZ_WL); }
__device__ __forceinline__ bf16* w_out_t(unsigned char* ws, int l) { return (bf16*)(ws + WS_W + (size_t)l * SZ_WL + SZ_WIN); }
__device__ __forceinline__ bf16* w_3_t(unsigned char* ws, int l) { return (bf16*)(ws + WS_W + (size_t)l * SZ_WL + SZ_WIN + SZ_WOUT); }
__device__ __forceinline__ bf16* w_dn_t(unsigned char* ws, int l) { return (bf16*)(ws + WS_W + (size_t)l * SZ_WL + SZ_WIN + SZ_WOUT + SZ_W3); }

__device__ __forceinline__ void phase0(const Frame& F, const Args& a) {
    LAS float* scr = (LAS float*)(F.lds + F.wave * 16384);
    const int gw = F.vcu * NWAVES + F.wave, NGW = F.G * NWAVES;
    for (int it = gw; it < DEPTH * IT_LAYER; it += NGW) {
        const int l = it / IT_LAYER; int r = it % IT_LAYER;
        if (r < IT_WIN) { const int nblk = DIN / 32, kb = r / nblk, nb = r % nblk, R0 = 32 * nb, pn = R0 >> 8, within = R0 & 255, hf = within >> 7, j0 = within & 127;
            int col0 = R0;
            if (pn == 1 || pn == 2) col0 = (hf ? 512 : 256) + (pn - 1) * 128 + j0; else if (pn >= 8) col0 = (hf ? 2304 : 2048) + (pn - 8) * 128 + j0;
            wt_item(a.in[8] + (size_t)l * D * DIN, DIN, col0, 64 * kb, w_in_t(a.ws, l), D, R0, 64 * kb, scr, F.lane); continue; }
        r -= IT_WIN;
        if (r < IT_WOUT) { const int nblk = D / 32, kb = r / nblk, nb = r % nblk;
            if (kb >= 4 && kb < 8) continue;
            wt_item(a.in[18] + (size_t)l * D * D, D, 32 * nb, 64 * kb, w_out_t(a.ws, l), D, 32 * nb, 64 * kb, scr, F.lane); continue; }
        r -= IT_WOUT;
        if (r < IT_W3) { const int nblk = 2 * DFF / 32, kb = r / nblk, nb = r % nblk, R0 = 32 * nb, pn = R0 >> 8, within = R0 & 255, bj = within >> 7, j0 = within & 127;
            const float* W = (bj ? a.in[22] : a.in[21]) + (size_t)l * D * DFF;
            wt_item(W, DFF, pn * 128 + j0, 64 * kb, w_3_t(a.ws, l), D, R0, 64 * kb, scr, F.lane); continue; }
        r -= IT_W3;
        { const int nblk = D / 32, kb = r / nblk, nb = r % nblk;
            wt_item(a.in[23] + (size_t)l * DFF * D, D, 32 * nb, 64 * kb, w_dn_t(a.ws, l), DFF, 32 * nb, 64 * kb, scr, F.lane); }
    }
    for (int it = gw; it < DEPTH * 4 * 16 * (D / 64); it += NGW) {
        const int nbk = it % (D / 64), cq = (it / (D / 64)) % 16, g = (it / (16 * (D / 64))) % 4, l = it / (4 * 16 * (D / 64)), n = nbk * 64 + F.lane;
        const float* wo = a.in[18] + (size_t)l * D * D + (size_t)(256 + 64 * g) * D + n;
        const float* pw = a.in[10] + (size_t)(l * 4 + g) * 4096 + cq * 4 * 64; const float* sc = a.in[11] + l * 256 + 64 * g;
        float* wpf = (float*)(a.ws + WS_WPF) + (size_t)l * 256 * D + (size_t)(64 * g + 4 * cq) * D + n;
        float s0 = 0.f, s1 = 0.f, s2 = 0.f, s3 = 0.f;
#pragma unroll 16
        for (int d = 0; d < 64; ++d) { const float wv = wo[(size_t)d * D] * sc[d]; s0 += pw[d] * wv; s1 += pw[64 + d] * wv; s2 += pw[128 + d] * wv; s3 += pw[192 + d] * wv; }
        wpf[0] = s0; wpf[D] = s1; wpf[2 * (size_t)D] = s2; wpf[3 * (size_t)D] = s3;
    }
    const float* g0 = a.in[6];
    for (int m = gw; m < M; m += NGW) {
        const float* xrow = (m < MP) ? a.in[0] + (size_t)m * D : a.in[1] + (size_t)(m - MP) * D;
        const GAS f32x4* xr = (const GAS f32x4*)xrow + F.lane;
        f32x4 v[4]; float s = 0.f;
#pragma unroll
        for (int j = 0; j < 4; ++j) { v[j] = xr[64 * j]; s += (v[j].x * v[j].x + v[j].y * v[j].y) + (v[j].z * v[j].z + v[j].w * v[j].w); }
        const float rs = 1.0f / sqrtf(wave_sum(s) * (1.f / D) + EPS);
        GAS f32x4* xo = (GAS f32x4*)(a.out + O_Y + (size_t)m * D) + F.lane;
        GAS v2u* o8 = (GAS v2u*)((bf16*)(a.ws + WS_XN) + (size_t)m * D) + F.lane;
#pragma unroll
        for (int j = 0; j < 4; ++j) { xo[64 * j] = v[j]; const f32x4 gg = *((const GAS f32x4*)g0 + F.lane + 64 * j);
            v2u w; w.x = pk2(v[j].x * rs * gg.x, v[j].y * rs * gg.y); w.y = pk2(v[j].z * rs * gg.z, v[j].w * rs * gg.w); o8[64 * j] = w; }
    }
}

__device__ __forceinline__ void phase_rows(const Frame& F, const Args& a, const bf16* mix, const float* ga, const float* gb  ) {
    const int gw = F.vcu * NWAVES + F.wave, NGW = F.G * NWAVES;
    for (int m = gw; m < M; m += NGW) {
        GAS f32x4* xo = (GAS f32x4*)(a.out + O_Y + (size_t)m * D) + F.lane;
        const GAS v2u* mr = (const GAS v2u*)(mix + (size_t)m * D) + F.lane;
        f32x4 x[4], mv[4]; float s = 0.f;
#pragma unroll
        for (int j = 0; j < 4; ++j) { x[j] = xo[64 * j]; const v2u w = mr[64 * j]; mv[j] = (f32x4){bflo(w.x), bfhi(w.x), bflo(w.y), bfhi(w.y)};
            s += (mv[j].x * mv[j].x + mv[j].y * mv[j].y) + (mv[j].z * mv[j].z + mv[j].w * mv[j].w); }
        const float rs = 1.0f / sqrtf(wave_sum(s) * (1.f / D) + EPS);
        float s2 = 0.f;
#pragma unroll
        for (int j = 0; j < 4; ++j) { const f32x4 gg = *((const GAS f32x4*)ga + F.lane + 64 * j); x[j] = x[j] + mv[j] * rs * gg; xo[64 * j] = x[j];
            s2 += (x[j].x * x[j].x + x[j].y * x[j].y) + (x[j].z * x[j].z + x[j].w * x[j].w); }
        if (gb) {
            const float rs2 = 1.0f / sqrtf(wave_sum(s2) * (1.f / D) + EPS);
            GAS v2u* o8 = (GAS v2u*)((bf16*)(a.ws + WS_XN) + (size_t)m * D) + F.lane;
#pragma unroll
            for (int j = 0; j < 4; ++j) { const f32x4 gg = *((const GAS f32x4*)gb + F.lane + 64 * j);
                v2u w; w.x = pk2(x[j].x * rs2 * gg.x, x[j].y * rs2 * gg.y); w.y = pk2(x[j].z * rs2 * gg.z, x[j].w * rs2 * gg.w); o8[64 * j] = w; }
        }
    }
}

__device__ __forceinline__ float hgrn_lower(const float* lbw, int l, int c) {
    if (l == 0) return 0.f;
    const float a0 = lbw[c], a1 = lbw[256 + c], mx = fmaxf(a0, a1), e0 = __expf(a0 - mx), e1 = __expf(a1 - mx);
    return e1 / (e0 + e1);
}
__device__ __forceinline__ void hgrn_scan_unit(const Frame& F, const Args& a, int l, int unit) {
    const int b = unit >> 5, h = (unit >> 3) & 3, vs = unit & 7;
    LAS float* SL = (LAS float*)F.lds;
    LAS float* VS = (LAS float*)(F.lds + 73728) + F.wave * 1024;
    const float* ZF = (const float*)(a.ws + WS_ZF) + (size_t)b * PS * 256 + h * 64 + F.lane;
    const bf16* PV = (const bf16*)(a.ws + WS_P) + ((size_t)b * PS + F.lane) * PW + 4 * 256 + h * 64 + vs * 8;
    float fa[32], fb[32];
#define M1_LOAD(farr, c, hf) do { const float* zp = ZF + ((size_t)(c) * 64 + (hf) * 32) * 256; _Pragma("unroll") for (int t = 0; t < 32; ++t) farr[t] = zp[t * 256]; } while (0)
#define M1_STEP(farr, hf) do { _Pragma("unroll") for (int t = 0; t < 32; ++t) { const float f = farr[t], k = 1.f - f; const f32x4 v0 = *(const LAS f32x4*)(VS + ((hf) * 32 + t) * 8), v1 = *(const LAS f32x4*)(VS + ((hf) * 32 + t) * 8 + 4); \
            S0_ = S0_ * f + v0 * k; S1_ = S1_ * f + v1 * k; Dp *= f; } } while (0)
#pragma unroll 1
    for (int ci = 0; ci < 4; ++ci) {
        const int c = F.wave + 8 * ci;
        M1_LOAD(fa, c, 0); M1_LOAD(fb, c, 1);
        const v4u vreg = *(const v4u*)(PV + (size_t)c * 64 * PW);
        *(LAS f32x4*)(VS + F.lane * 8) = (f32x4){bflo(vreg.x), bfhi(vreg.x), bflo(vreg.y), bfhi(vreg.y)}; *(LAS f32x4*)(VS + F.lane * 8 + 4) = (f32x4){bflo(vreg.z), bfhi(vreg.z), bflo(vreg.w), bfhi(vreg.w)};
        f32x4 S0_ = (f32x4){0.f, 0.f, 0.f, 0.f}, S1_ = S0_; float Dp = 1.f;
        M1_STEP(fa, 0); M1_STEP(fb, 1);
        LAS float* o = SL + (c * 64 + F.lane) * 9; o[0] = S0_.x; o[1] = S0_.y; o[2] = S0_.z; o[3] = S0_.w; o[4] = S1_.x; o[5] = S1_.y; o[6] = S1_.z; o[7] = S1_.w; o[8] = Dp;
    }
#undef M1_STEP
#undef M1_LOAD
    __syncthreads();
    {   const int k = F.tid & 63, v = F.tid >> 6;
        float* S0 = (float*)(a.ws + WS_S0) + ((size_t)(b * 4 + h) * NCH) * 4096 + (size_t)(vs * 8 + v) * 64 + k;
        float S = 0.f;
#pragma unroll 8
        for (int c = 0; c < NCH; ++c) { S0[(size_t)c * 4096] = S; const LAS float* e = SL + (c * 64 + k) * 9; S = e[8] * S + e[v]; }
        a.out[O_HGRNP + ((size_t)(b * DEPTH + l) * 4 + h) * 4096 + k * 64 + vs * 8 + v] = S;
    }
    __syncthreads();
}

__device__ __forceinline__ void mm64(const LAS unsigned char* A, const LAS unsigned char* Bt, f32x4 (&acc)[2], int wave, int lane) {
    const int rs = wave >> 1, ch = wave & 1, fr = lane & 15, fq = lane >> 4;
#pragma unroll
    for (int ks = 0; ks < 2; ++ks) {
        const bf16x8 av = *(const LAS bf16x8*)(A + (16 * rs + fr) * 144 + (ks * 32 + 8 * fq) * 2);
#pragma unroll
        for (int nt = 0; nt < 2; ++nt) {
            const bf16x8 bv = *(const LAS bf16x8*)(Bt + (32 * ch + 16 * nt + fr) * 144 + (ks * 32 + 8 * fq) * 2);
            acc[nt] = __builtin_amdgcn_mfma_f32_16x16x32_bf16(av, bv, acc[nt], 0, 0, 0);
        }
    }
}

__device__ __forceinline__ void hgrn_out_unit(const Frame& F, const Args& a, int l, int unit) {
    const int b = unit >> 7, c = (unit >> 2) & 31, h = unit & 3;
    const size_t row0 = (size_t)b * PS + c * 64;
    LAS unsigned char* QT = F.lds, *KT = F.lds + 9216, *VT = F.lds + 18432, *AM = F.lds + 27648, *ST = F.lds + 36864;
    LAS float* OF = (LAS float*)(F.lds + 46080);
    LAS float* PART = (LAS float*)(F.lds + 62720);
    LAS float* ER = (LAS float*)(F.lds + 64768);
    const float* ZF = (const float*)(a.ws + WS_ZF); const bf16* P = (const bf16*)(a.ws + WS_P);
    const int k = F.tid & 63, part = F.tid >> 6, s8 = F.tid >> 3, v0 = (F.tid & 7) * 8;
    float fv[8]; unsigned qraw[8];
#pragma unroll
    for (int i = 0; i < 8; ++i) { const size_t row = row0 + part * 8 + i; fv[i] = ZF[row * 256 + h * 64 + k]; qraw[i] = P[row * PW + 3 * 256 + h * 64 + k]; }
    const v4u vv = *(const v4u*)(P + (row0 + s8) * PW + 4 * 256 + h * 64 + v0);
    const v4u gv = *(const v4u*)(P + (row0 + s8) * PW + 5 * 256 + h * 64 + v0);
    const float* S0p = (const float*)(a.ws + WS_S0) + ((size_t)(b * 4 + h) * NCH + c) * 4096 + s8 * 64 + v0;
    const f32x4 s0 = *(const f32x4*)S0p, s1 = *(const f32x4*)(S0p + 4);
    const f32x4 ng0 = *(const f32x4*)(a.in[13] + l * 256 + h * 64 + v0), ng1 = *(const f32x4*)(a.in[13] + l * 256 + h * 64 + v0 + 4);
    {
        float lf[8]; float tot = 0.f;
#pragma unroll
        for (int i = 0; i < 8; ++i) { tot += __logf(fv[i]); lf[i] = tot; }
        PART[part * 64 + k] = tot;
        __syncthreads();
        float base = 0.f, r = 0.f;
#pragma unroll
        for (int p = 0; p < 8; ++p) { const float t = PART[p * 64 + k]; if (p < part) base += t; if (p < 4) r += t; }
        if (part == 0) ER[k] = __expf(r);
#pragma unroll
        for (int i = 0; i < 8; ++i) { const float bb = base + lf[i]; const int t = part * 8 + i;
            *(LAS bf16*)(QT + t * 144 + k * 2) = (bf16)f2bf(bf2f(qraw[i]) * __expf(bb - r));
            *(LAS bf16*)(KT + t * 144 + k * 2) = (bf16)f2bf((1.f - fv[i]) * __expf(r - bb)); }
    }
    {
        const unsigned w[4] = {vv.x, vv.y, vv.z, vv.w};
#pragma unroll
        for (int j = 0; j < 4; ++j) { *(LAS bf16*)(VT + (v0 + 2 * j) * 144 + s8 * 2) = (bf16)(w[j] & 0xffffu); *(LAS bf16*)(VT + (v0 + 2 * j + 1) * 144 + s8 * 2) = (bf16)(w[j] >> 16); }
    }
    __syncthreads();
    {
        const int k0 = v0;
        v4u o; o.x = pk2(s0.x * ER[k0], s0.y * ER[k0 + 1]); o.y = pk2(s0.z * ER[k0 + 2], s0.w * ER[k0 + 3]); o.z = pk2(s1.x * ER[k0 + 4], s1.y * ER[k0 + 5]); o.w = pk2(s1.z * ER[k0 + 6], s1.w * ER[k0 + 7]);
        *(LAS v4u*)(ST + s8 * 144 + k0 * 2) = o;
    }
    f32x4 acc[2] = {(f32x4){0.f, 0.f, 0.f, 0.f}, (f32x4){0.f, 0.f, 0.f, 0.f}};
    mm64(QT, KT, acc, F.wave, F.lane);
    {   const int rs = F.wave >> 1, ch = F.wave & 1, fr = F.lane & 15, fq = F.lane >> 4;
#pragma unroll
        for (int nt = 0; nt < 2; ++nt)
#pragma unroll
            for (int e = 0; e < 4; ++e) { const int t = 16 * rs + 4 * fq + e, s = 32 * ch + 16 * nt + fr;
                *(LAS bf16*)(AM + t * 144 + s * 2) = (bf16)((s <= t) ? f2bf(acc[nt][e]) : 0u); }
    }
    __syncthreads();
    acc[0] = (f32x4){0.f, 0.f, 0.f, 0.f}; acc[1] = (f32x4){0.f, 0.f, 0.f, 0.f};
    mm64(AM, VT, acc, F.wave, F.lane);
    mm64(QT, ST, acc, F.wave, F.lane);
    {   const int rs = F.wave >> 1, ch = F.wave & 1, fr = F.lane & 15, fq = F.lane >> 4;
#pragma unroll
        for (int nt = 0; nt < 2; ++nt)
#pragma unroll
            for (int e = 0; e < 4; ++e) OF[(16 * rs + 4 * fq + e) * 65 + 32 * ch + 16 * nt + fr] = acc[nt][e];
    }
    __syncthreads();
    {
        const int t = s8;
        float o[8]; float ss = 0.f;
#pragma unroll
        for (int j = 0; j < 8; ++j) { o[j] = OF[t * 65 + v0 + j]; ss += o[j] * o[j]; }
        ss += __shfl_xor(ss, 1); ss += __shfl_xor(ss, 2); ss += __shfl_xor(ss, 4);
        const float rsq = 1.0f / sqrtf(ss * (1.f / 64.f) + EPS);
        const float ng[8] = {ng0.x, ng0.y, ng0.z, ng0.w, ng1.x, ng1.y, ng1.z, ng1.w};
        const float g[8] = {bflo(gv.x), bfhi(gv.x), bflo(gv.y), bfhi(gv.y), bflo(gv.z), bfhi(gv.z), bflo(gv.w), bfhi(gv.w)};
        float y[8];
#pragma unroll
        for (int j = 0; j < 8; ++j) y[j] = o[j] * rsq * ng[j] * g[j];
        v4u w; w.x = pk2(y[0], y[1]); w.y = pk2(y[2], y[3]); w.z = pk2(y[4], y[5]); w.w = pk2(y[6], y[7]);
        *(GAS v4u*)((bf16*)(a.ws + WS_Y) + (row0 + t) * D + 512 + h * 64 + v0) = w;
    }
    __syncthreads();
}

__device__ __forceinline__ void hgrn_sample_unit(const Frame& F, const Args& a, int l, int unit) {
    const int b = unit >> 2, h = unit & 3, v = F.tid & 63, kg = F.tid >> 6;
    const size_t row0 = (size_t)MP + b * SS;
    LAS float* PT = (LAS float*)F.lds;
    const float* ZF = (const float*)(a.ws + WS_ZF); const bf16* P = (const bf16*)(a.ws + WS_P);
    const float* sin_ = a.in[4] + ((size_t)(b * DEPTH + l) * 4 + h) * 4096;
    float S[8];
#pragma unroll
    for (int j = 0; j < 8; ++j) S[j] = sin_[(kg * 8 + j) * 64 + v];
    float vt[SS]; v4u qq[SS]; f32x4 z0[SS], z1[SS];
#pragma unroll
    for (int t = 0; t < SS; ++t) { const size_t row = row0 + t;
        vt[t] = bf2f(P[row * PW + 4 * 256 + h * 64 + v]); qq[t] = *(const v4u*)(P + row * PW + 3 * 256 + h * 64 + kg * 8);
        z0[t] = *(const f32x4*)(ZF + row * 256 + h * 64 + kg * 8); z1[t] = *(const f32x4*)(ZF + row * 256 + h * 64 + kg * 8 + 4); }
#pragma unroll
    for (int t = 0; t < SS; ++t) {
        const float f[8] = {z0[t].x, z0[t].y, z0[t].z, z0[t].w, z1[t].x, z1[t].y, z1[t].z, z1[t].w};
        const float q[8] = {bflo(qq[t].x), bfhi(qq[t].x), bflo(qq[t].y), bfhi(qq[t].y), bflo(qq[t].z), bfhi(qq[t].z), bflo(qq[t].w), bfhi(qq[t].w)};
        float op = 0.f;
#pragma unroll
        for (int j = 0; j < 8; ++j) { S[j] = f[j] * S[j] + (1.f - f[j]) * vt[t]; op += S[j] * q[j]; }
        PT[(t * 8 + kg) * 64 + v] = op;
    }
    float* sout = a.out + O_HGRNS + ((size_t)(b * DEPTH + l) * 4 + h) * 4096;
#pragma unroll
    for (int j = 0; j < 8; ++j) sout[(kg * 8 + j) * 64 + v] = S[j];
    __syncthreads();
    {
        const int t = F.wave; float o = 0.f;
#pragma unroll
        for (int g = 0; g < 8; ++g) o += PT[(t * 8 + g) * 64 + F.lane];
        const float rsq = 1.0f / sqrtf(wave_sum(o * o) * (1.f / 64.f) + EPS);
        const size_t row = row0 + t;
        const float gt = bf2f(P[row * PW + 5 * 256 + h * 64 + F.lane]);
        const float y = o * rsq * a.in[13][l * 256 + h * 64 + F.lane] * gt;
        ((bf16*)(a.ws + WS_Y))[row * D + 512 + h * 64 + F.lane] = (bf16)f2bf(y);
    }
    __syncthreads();
}

__device__ __forceinline__ void st8(LAS float* dst, const v4u w) { *(LAS f32x4*)dst = (f32x4){bflo(w.x), bfhi(w.x), bflo(w.y), bfhi(w.y)}; *(LAS f32x4*)(dst + 4) = (f32x4){bflo(w.z), bfhi(w.z), bflo(w.w), bfhi(w.w)}; }
template <bool SAMPLE>
__device__ __forceinline__ void mix_abd_unit(const Frame& F, const Args& a, int l, int unit) {
    constexpr int SEG = SAMPLE ? 8 : 32, NT = SEG / 2, HR = 30, HP = 15;
    constexpr int NU = (HR + SEG) * 32, NP_ = (HP + SEG) * 32;
    constexpr int KU = (NU + 511) / 512, KP = (NP_ + 511) / 512;
    const size_t row0 = SAMPLE ? (size_t)MP + unit * SS : (size_t)unit * 32;
    const int tpos0 = SAMPLE ? 0 : (unit * 32) % PS;
    const int c = F.tid & 255, th = F.tid >> 8;
    LAS float* U = (LAS float*)F.lds;
    LAS float* CV = U + (HR + SEG) * 256;
    LAS float* PB = CV + SEG * 256;
    const bf16* P = (const bf16*)(a.ws + WS_P);
    bf16* Y = (bf16*)(a.ws + WS_Y);
    const v4u zero4 = (v4u){0u, 0u, 0u, 0u};
    v4u ur[KU], pr[KP]; f32x4 uh0[KU], uh1[KU], ph0[KP], ph1[KP];
#pragma unroll
    for (int k = 0; k < KU; ++k) { const int idx = F.tid + 512 * k, i = idx >> 5, cg = idx & 31, tau = i - HR; ur[k] = zero4; uh0[k] = (f32x4){0.f, 0.f, 0.f, 0.f}; uh1[k] = uh0[k];
        if (idx < NU) {
            if (tau >= 0 || (!SAMPLE && tpos0 + tau >= 0)) ur[k] = *(const v4u*)(P + (row0 + tau) * PW + 6 * 256 + 8 * cg);
            else if (SAMPLE) { const float* hp = a.in[5] + ((size_t)(unit * DEPTH + l) * 30 + (30 + tau)) * 256 + 8 * cg; uh0[k] = *(const f32x4*)hp; uh1[k] = *(const f32x4*)(hp + 4); } } }
#pragma unroll
    for (int k = 0; k < KP; ++k) { const int idx = F.tid + 512 * k, i = idx >> 5, cg = idx & 31, tau = i - HP; pr[k] = zero4; ph0[k] = (f32x4){0.f, 0.f, 0.f, 0.f}; ph1[k] = ph0[k];
        if (idx < NP_) {
            if (tau >= 0 || (!SAMPLE && tpos0 + tau >= 0)) pr[k] = *(const v4u*)(P + (row0 + tau) * PW + 2 * 256 + 8 * cg);
            else if (SAMPLE) { const float* hp = a.in[3] + ((size_t)(unit * DEPTH + l) * 15 + (15 + tau)) * 256 + 8 * cg; ph0[k] = *(const f32x4*)hp; ph1[k] = *(const f32x4*)(hp + 4); } } }
    constexpr int TA = SAMPLE ? 1 : 2;
    const int cgA = F.tid & 31, tsA = F.tid >> 5; const bool actA = SAMPLE ? (tsA < 8) : true;
    v4u vr[TA + 2], abr[TA]; f32x4 vh0[2], vh1[2];
#pragma unroll
    for (int j = 0; j < TA + 2; ++j) { const int tau = tsA * TA - 2 + j; vr[j] = zero4;
        if (j < 2) { vh0[j] = (f32x4){0.f, 0.f, 0.f, 0.f}; vh1[j] = vh0[j]; }
        if (actA) {
            if (tau >= 0 || (!SAMPLE && tpos0 + tau >= 0)) vr[j] = *(const v4u*)(P + (row0 + tau) * PW + 1 * 256 + 8 * cgA);
            else if (SAMPLE && j < 2) { const float* hp = a.in[2] + ((size_t)(unit * DEPTH + l) * 2 + (2 + tau)) * 256 + 8 * cgA; vh0[j] = *(const f32x4*)hp; vh1[j] = *(const f32x4*)(hp + 4); } } }
#pragma unroll
    for (int j = 0; j < TA; ++j) abr[j] = actA ? *(const v4u*)(P + (row0 + tsA * TA + j) * PW + 8 * cgA) : zero4;
#pragma unroll
    for (int k = 0; k < KU; ++k) { const int idx = F.tid + 512 * k, i = idx >> 5, cg = idx & 31, tau = i - HR;
        if (idx < NU) { LAS float* d = U + i * 256 + 8 * cg;
            if (SAMPLE && tau < 0) { *(LAS f32x4*)d = uh0[k]; *(LAS f32x4*)(d + 4) = uh1[k]; } else st8(d, ur[k]); } }
#pragma unroll
    for (int k = 0; k < KP; ++k) { const int idx = F.tid + 512 * k, i = idx >> 5, cg = idx & 31, tau = i - HP;
        if (idx < NP_) { LAS float* d = PB + i * 256 + 8 * cg;
            if (SAMPLE && tau < 0) { *(LAS f32x4*)d = ph0[k]; *(LAS f32x4*)(d + 4) = ph1[k]; } else st8(d, pr[k]); } }
    if (actA) {
        const float* cw = a.in[9] + (size_t)l * 3 * 256 + 8 * cgA;
        float vf[TA + 2][8];
#pragma unroll
        for (int j = 0; j < TA + 2; ++j) { const int tau = tsA * TA - 2 + j;
            if (SAMPLE && j < 2 && tau < 0) { vf[j][0] = vh0[j].x; vf[j][1] = vh0[j].y; vf[j][2] = vh0[j].z; vf[j][3] = vh0[j].w; vf[j][4] = vh1[j].x; vf[j][5] = vh1[j].y; vf[j][6] = vh1[j].z; vf[j][7] = vh1[j].w; }
            else { vf[j][0] = bflo(vr[j].x); vf[j][1] = bfhi(vr[j].x); vf[j][2] = bflo(vr[j].y); vf[j][3] = bfhi(vr[j].y); vf[j][4] = bflo(vr[j].z); vf[j][5] = bfhi(vr[j].z); vf[j][6] = bflo(vr[j].w); vf[j][7] = bfhi(vr[j].w); } }
        float w0[8], w1[8], w2[8];
#pragma unroll
        for (int e = 0; e < 8; ++e) { w0[e] = cw[e]; w1[e] = cw[256 + e]; w2[e] = cw[512 + e]; }
#pragma unroll
        for (int j = 0; j < TA; ++j) { const float ab[8] = {bflo(abr[j].x), bfhi(abr[j].x), bflo(abr[j].y), bfhi(abr[j].y), bflo(abr[j].z), bfhi(abr[j].z), bflo(abr[j].w), bfhi(abr[j].w)};
            float y[8];
#pragma unroll
            for (int e = 0; e < 8; ++e) y[e] = ab[e] * (w0[e] * vf[j][e] + w1[e] * vf[j + 1][e] + w2[e] * vf[j + 2][e]);
            v4u w; w.x = pk2(y[0], y[1]); w.y = pk2(y[2], y[3]); w.z = pk2(y[4], y[5]); w.w = pk2(y[6], y[7]);
            *(GAS v4u*)(Y + (row0 + tsA * TA + j) * D + 8 * cgA) = w; }
    }
    __syncthreads();
    {   float w[31], acc[NT];
#pragma unroll
        for (int j = 0; j < 31; ++j) w[j] = a.in[14][(size_t)(l * 31 + j) * 256 + c];
        const float bias = a.in[15][l * 256 + c];
#pragma unroll
        for (int o = 0; o < NT; ++o) acc[o] = bias;
#pragma unroll
        for (int ii = 0; ii < NT + 30; ++ii) { const float val = U[(th * NT + ii) * 256 + c];
#pragma unroll
            for (int o = 0; o < NT; ++o) { if (ii - o >= 0 && ii - o <= 30) acc[o] += w[ii - o] * val; } }
#pragma unroll
        for (int o = 0; o < NT; ++o) CV[(th * NT + o) * 256 + c] = acc[o];
    }
    {   const int wlen = 2 << (c >> 6); const int t0 = th * NT;
        float s = 0.f;
        for (int j = 1; j < wlen; ++j) s += PB[(HP + t0 - j) * 256 + c];
#pragma unroll 4
        for (int o = 0; o < NT; ++o) { const int tau = t0 + o; const float p0 = PB[(HP + tau) * 256 + c]; s += p0;
            const int cnt = SAMPLE ? wlen : min(tpos0 + tau + 1, wlen);
            Y[(row0 + tau) * D + 256 + c] = (bf16)f2bf(s / (float)cnt - p0);
            s -= PB[(HP + tau - wlen + 1) * 256 + c]; }
    }
    __syncthreads();
    {   const f32x4 lg = *((const GAS f32x4*)(a.in[16] + l * 256) + F.lane), lbv = *((const GAS f32x4*)(a.in[17] + l * 256) + F.lane);
        for (int t = F.wave; t < SEG; t += 8) {
            const f32x4 x = *(const LAS f32x4*)(CV + t * 256 + 4 * F.lane);
            const float mean = wave_sum((x.x + x.y) + (x.z + x.w)) * (1.f / 256.f);
            const f32x4 d = x - mean;
            const float var = wave_sum((d.x * d.x + d.y * d.y) + (d.z * d.z + d.w * d.w)) * (1.f / 256.f);
            const float rstd = 1.0f / sqrtf(var + EPS);
            const f32x4 y = d * rstd * lg + lbv;
            v2u w; w.x = pk2(fsilu(y.x), fsilu(y.y)); w.y = pk2(fsilu(y.z), fsilu(y.w));
            *((GAS v2u*)(Y + (row0 + t) * D + 768) + F.lane) = w;
        }
    }
    __syncthreads();
}

__device__ __forceinline__ void state_outputs(const Frame& F, const Args& a, int l) {
    const bf16* P = (const bf16*)(a.ws + WS_P);
    const int NTH = F.G * NWAVES * 64, gt = (F.vcu * NWAVES + F.wave) * 64 + F.lane;
    constexpr int NP = 8 * (2 + 15 + 30) * 256, NS = 128 * (2 + 15 + 30) * 256;
    for (int e = gt; e < NP + NS; e += NTH) {
        const bool smp = e >= NP; const int r = smp ? e - NP : e; const int c = r & 255, i47 = (r >> 8) % 47, b = (r >> 8) / 47;
        int kind, i; if (i47 < 2) { kind = 0; i = i47; } else if (i47 < 17) { kind = 1; i = i47 - 2; } else { kind = 2; i = i47 - 17; }
        const int len = kind == 0 ? 2 : (kind == 1 ? 15 : 30);
        float val;
        const int tau = (smp ? SS : PS) - len + i;
        if (tau >= 0) { const size_t row = smp ? (size_t)MP + b * SS + tau : (size_t)b * PS + tau;
            val = bf2f(P[row * PW + (kind == 0 ? 1 : (kind == 1 ? 2 : 6)) * 256 + c]);
        } else { const float* src = kind == 0 ? a.in[2] : (kind == 1 ? a.in[3] : a.in[5]);
            val = src[((size_t)(b * DEPTH + l) * len + (len + tau)) * 256 + c]; }
        const size_t obase = smp ? (kind == 0 ? O_CONVS : (kind == 1 ? O_POOLS : O_CONFS)) : (kind == 0 ? O_CONVP : (kind == 1 ? O_POOLP : O_CONFP));
        a.out[obase + ((size_t)(b * DEPTH + l) * len + i) * 256 + c] = val;
    }
}

__device__ __forceinline__ void fold_rows(const Frame& F, const Args& a) {
    LAS float* scr = (LAS float*)(F.lds + F.wave * 16384);
    const int gw = F.vcu * NWAVES + F.wave, NGW = F.G * NWAVES;
    for (int it = gw; it < DEPTH * 4 * (D / 32); it += NGW) {
        const int l = it / (4 * (D / 32)), r = it % (4 * (D / 32)), kb = r / (D / 32), nb = r % (D / 32);
        wt_item((const float*)(a.ws + WS_WPF) + (size_t)l * 256 * D, D, 32 * nb, 64 * kb, w_out_t(a.ws, l), D, 32 * nb, 256 + 64 * kb, scr, F.lane);
    }
}

constexpr int N_PHASES = 1 + 8 * DEPTH;
constexpr int M2_UNITS = 1024 + 512 + 128 + 512;
__global__ void __launch_bounds__(NWAVES * 64, 2) mk_fwd(Args args) {
    extern __shared__ __attribute__((aligned(16))) unsigned char lds[];
    Frame F;
    F.lds = (LAS unsigned char*)lds;
    F.tid = threadIdx.x; F.lane = F.tid & 63; F.wave = __builtin_amdgcn_readfirstlane(F.tid >> 6);
    F.G = gridDim.x; { const int bx = blockIdx.x; F.vcu = (F.G % 8 == 0) ? (bx % 8) * (F.G / 8) + bx / 8 : bx; }
    volatile LAS unsigned* MISC = (volatile LAS unsigned*)(F.lds + MISC_OFF);
    for (int u = F.tid; u < 64; u += NWAVES * 64) MISC[u] = 0u;
    __syncthreads();
    unsigned char* ws = args.ws;
#if MK_N_LAUNCHES == 1
    XcdBarrier bar = xcd_barrier_post((unsigned*)(ws + WS_CTL) + CW_BAR, MISC + 8);
#define GRID_BAR() xcd_barrier(bar)
#else
#define GRID_BAR() do {} while (0)
#endif
    const int lo = args.ph_lo, hi = args.ph_hi;
#ifndef DUP_MASK
#define DUP_MASK 0u
#endif
#ifdef ONLYPH
#define IN(k) ((k) == ONLYPH && lo <= (k))
#else
#define IN(k) (lo <= (k) && (k) < hi)
#endif
#define SEAM(k) do { if (IN(k) && IN((k) + 1)) GRID_BAR(); } while (0)
#define RUN(k, body) do { if (IN(k)) { body; if ((DUP_MASK >> (k)) & 1u) { GRID_BAR(); body; } } SEAM(k); } while (0)
#define PH_G1(l) { pg8::Gemm g{(const bf16*)(ws + WS_XN), w_in_t(ws, l), M, DIN, D}; pg8::StaticOrder S; S.init(M, DIN, F.G, (int)blockIdx.x); \
        pg8::EpiP2 E{(bf16*)(ws + WS_P), (float*)(ws + WS_ZF), args.in[12], l}; pg8::gemm_phase<pg8::EpiP2, pg8::StaticOrder, true, true>(F.lds, g, S, E); }
#define PH_M1(l) { if ((l) == 0) { fold_rows(F, args); __syncthreads(); } for (int it = F.vcu; it < 256; it += F.G) hgrn_scan_unit(F, args, l, it); }
#define PH_M2(l) { for (int it = F.vcu; it < 1024; it += F.G) hgrn_out_unit(F, args, l, it); \
        for (int it = F.vcu; it < 512; it += F.G) mix_abd_unit<false>(F, args, l, it); \
        for (int it = F.G - 1 - F.vcu; it < 128; it += F.G) mix_abd_unit<true>(F, args, l, it); \
        for (int it = F.vcu; it < 512; it += F.G) hgrn_sample_unit(F, args, l, it); \
        state_outputs(F, args, l); }
#define PH_G2(l) { pg8::Gemm g{(const bf16*)(ws + WS_Y), w_out_t(ws, l), M, D, D}; pg8::StaticOrder S; S.init(M, D, F.G, (int)blockIdx.x); \
        pg8::EpiBf E{(bf16*)(ws + WS_MIX2), D}; pg8::gemm_phase<pg8::EpiBf, pg8::StaticOrder, true, true>(F.lds, g, S, E); }
#define PH_R2(l) { phase_rows(F, args, (const bf16*)(ws + WS_MIX2), args.in[7] + (l) * D, args.in[19] + (l) * D); }
#define PH_G3(l) { pg8::Gemm g{(const bf16*)(ws + WS_XN), w_3_t(ws, l), M, 2 * DFF, D}; pg8::StaticOrder S; S.init(M, 2 * DFF, F.G, (int)blockIdx.x); \
        pg8::EpiAct E{(bf16*)(ws + WS_ACT), DFF}; pg8::gemm_phase<pg8::EpiAct, pg8::StaticOrder, true, true>(F.lds, g, S, E); }
#define PH_G4(l) { pg8::Gemm g{(const bf16*)(ws + WS_ACT), w_dn_t(ws, l), M, D, DFF}; pg8::StaticOrder S; S.init(M, D, F.G, (int)blockIdx.x); \
        pg8::EpiBf E{(bf16*)(ws + WS_MIX4), D}; pg8::gemm_phase<pg8::EpiBf, pg8::StaticOrder, true, true>(F.lds, g, S, E); }
#define PH_R4(l) { phase_rows(F, args, (const bf16*)(ws + WS_MIX4), args.in[20] + (l) * D, ((l) + 1 < DEPTH) ? args.in[6] + ((l) + 1) * D : nullptr); }
    RUN(0, { phase0(F, args); });
#define LAYER(l) RUN(1 + 8 * (l), PH_G1(l)); RUN(2 + 8 * (l), PH_M1(l)); RUN(3 + 8 * (l), PH_M2(l)); RUN(4 + 8 * (l), PH_G2(l)); RUN(5 + 8 * (l), PH_R2(l)); \
                 RUN(6 + 8 * (l), PH_G3(l)); RUN(7 + 8 * (l), PH_G4(l)); RUN(8 + 8 * (l), PH_R4(l));
    LAYER(0)
    LAYER(1)
#undef LAYER
#undef IN
#undef SEAM
}

extern "C" void kernel_launch(void* const* d_in, const int* in_sizes, int n_in, void* d_out, int out_size, void* d_ws, size_t ws_size, hipStream_t stream) {
    static int grid = 0;
    if (grid == 0) {
        if (n_in != 24 || out_size != (int)O_END || ws_size < WS_END) { fprintf(stderr, "kernel_launch: unexpected sizes n_in %d out %d ws %zu\n", n_in, out_size, ws_size); grid = -1; return; }
        int dev = 0, cus = 0;
        if (hipGetDevice(&dev) != hipSuccess || hipDeviceGetAttribute(&cus, hipDeviceAttributeMultiprocessorCount, dev) != hipSuccess) { grid = -1; return; }
        if (hipFuncSetAttribute((const void*)mk_fwd, hipFuncAttributeMaxDynamicSharedMemorySize, LDS_BYTES) != hipSuccess) { fprintf(stderr, "kernel_launch: hipFuncSetAttribute failed\n"); grid = -1; return; }
        int per_cu = 0;
        if (hipOccupancyMaxActiveBlocksPerMultiprocessor(&per_cu, (const void*)mk_fwd, NWAVES * 64, LDS_BYTES) != hipSuccess || per_cu < 1) fprintf(stderr, "kernel_launch: occupancy query says %d\n", per_cu);
        (void)hipGetLastError();
        grid = cus;
    }
    if (grid < 0) return;
    if (hipMemsetAsync((char*)d_ws + WS_CTL, 0, CTL_ZERO_BYTES, stream) != hipSuccess) return;
    Args a{};
    for (int i = 0; i < 24; ++i) a.in[i] = (const float*)d_in[i];
    a.out = (float*)d_out; a.ws = (unsigned char*)d_ws;
#if MK_N_LAUNCHES == 1
    a.ph_lo = 0; a.ph_hi = N_PHASES; a.li = 0;
    hipLaunchKernelGGL(mk_fwd, dim3(grid), dim3(NWAVES * 64), LDS_BYTES, stream, a);
#else
    for (int ph = 0; ph < N_PHASES; ++ph) { a.ph_lo = ph; a.ph_hi = ph + 1; a.li = ph;
        hipLaunchKernelGGL(mk_fwd, dim3(grid), dim3(NWAVES * 64), LDS_BYTES, stream, a); }
#endif
}
```
